# Optimizing an MI355X kernel written in HIP

```python
import math
import jax, jax.numpy as jnp
from jax import lax
import numpy as np

D_MODEL = 1024
BATCH = 32
SEQ = 2048
DEPTH = 2

GRID_W = 64
CTX_LEN = 256
N_HEADS = 8
N_KV_HEADS = 2
HEAD_DIM = D_MODEL // N_HEADS
Q_PER_KV = N_HEADS // N_KV_HEADS
ROPE_THETA = 10000.0
Q_BLOCK = 128
CONV_WIDTH = D_MODEL // 2
CONV_TAPS = 3
SGU_WIDTH = D_MODEL // 2
SGU_GROUPS = 8
SGU_GROUP_DIM = SGU_WIDTH // SGU_GROUPS
CHUNK = 128
MIX_IN = 3 * CONV_WIDTH + 2 * SGU_WIDTH
MIX_OUT = CONV_WIDTH + SGU_WIDTH
FFN_HIDDEN = -(-8 * D_MODEL // (3 * 256)) * 256
ALPHA = (2.0 * DEPTH) ** 0.25
BETA = (8.0 * DEPTH) ** -0.25
N_EVEN = (DEPTH + 1) // 2
N_ODD = DEPTH // 2
LN_EPS = 1e-5
RMS_EPS = 1e-6

kernel_name = "hybrid_conv_sgu_gqa_prefix_deepnorm"


def _layernorm(x, g, b):
    xf = x.astype(jnp.float32)
    mu = jnp.mean(xf, axis=-1, keepdims=True)
    var = jnp.mean(jnp.square(xf - mu), axis=-1, keepdims=True)
    y = (xf - mu) * lax.rsqrt(var + LN_EPS) * g.astype(jnp.float32) + b.astype(jnp.float32)
    return y.astype(x.dtype)


def _rmsnorm(x, g):
    xf = x.astype(jnp.float32)
    y = xf * lax.rsqrt(jnp.mean(jnp.square(xf), axis=-1, keepdims=True) + RMS_EPS) * g.astype(jnp.float32)
    return y.astype(x.dtype)


def _modulate(h, shift, scale):
    return h * (1.0 + scale) + shift


def _post_norm(x, y, gate, g, b):
    return _layernorm(ALPHA * x + gate * y, g, b)


def _swiglu(h, w_in, w_out):
    gt, up = jnp.split(h @ w_in, 2, axis=-1)
    return (jax.nn.silu(gt) * up) @ w_out


def _sgu(u, v, ln_g, ln_b, w_s, b_s):
    bsz, n, _ = v.shape
    v = _layernorm(v, ln_g, ln_b).reshape(bsz, n // CHUNK, CHUNK, SGU_GROUPS, SGU_GROUP_DIM)
    s = jnp.einsum('gpq,bcqgd->bcpgd', w_s, v) + b_s.T[None, None, :, :, None]
    return u * s.reshape(bsz, n, SGU_WIDTH)


def _conv_chunk_mixer(h, w_in, conv_w, sgu_ln_g, sgu_ln_b, sgu_w, sgu_b, w_out):
    p = h @ w_in
    g_b, g_c, hv, u, v = jnp.split(
        p, [CONV_WIDTH, 2 * CONV_WIDTH, 3 * CONV_WIDTH, 3 * CONV_WIDTH + SGU_WIDTH], axis=-1)
    z = g_c * hv
    zp = jnp.pad(z, ((0, 0), (1, 1), (0, 0)))
    zc = conv_w[0] * zp[:, :-2] + conv_w[1] * zp[:, 1:-1] + conv_w[2] * zp[:, 2:]
    y_a = g_b * zc
    y_b = _sgu(jax.nn.gelu(u, approximate=False), jax.nn.gelu(v, approximate=False),
               sgu_ln_g, sgu_ln_b, sgu_w, sgu_b)
    return jnp.concatenate([y_a, y_b], axis=-1) @ w_out


def _axial_tables(n):
    rows = n // GRID_W
    row = jnp.repeat(jnp.arange(rows, dtype=jnp.float32), GRID_W)
    col = jnp.tile(jnp.arange(GRID_W, dtype=jnp.float32), rows)
    n_freq = HEAD_DIM // 4
    inv = ROPE_THETA ** (-jnp.arange(n_freq, dtype=jnp.float32) / n_freq)
    ang_r = row[:, None] * inv
    ang_c = col[:, None] * inv
    return (jnp.cos(ang_r)[None, :, None, :], jnp.sin(ang_r)[None, :, None, :],
            jnp.cos(ang_c)[None, :, None, :], jnp.sin(ang_c)[None, :, None, :])


def _rotate(x, cos, sin):
    x1, x2 = jnp.split(x, 2, axis=-1)
    return jnp.concatenate([x1 * cos - x2 * sin, x2 * cos + x1 * sin], axis=-1)


def _axial_rope(x, tables):
    cos_r, sin_r, cos_c, sin_c = tables
    xf = x.astype(jnp.float32)
    xr, xc = jnp.split(xf, 2, axis=-1)
    return jnp.concatenate([_rotate(xr, cos_r, sin_r), _rotate(xc, cos_c, sin_c)], axis=-1).astype(x.dtype)


def _proj_q(h, w_q, q_g):
    bsz, n, _ = h.shape
    return _rmsnorm((h @ w_q).reshape(bsz, n, N_HEADS, HEAD_DIM), q_g)


def _proj_kv(h, w_kv, k_g):
    bsz, n, _ = h.shape
    k, v = jnp.split((h @ w_kv).reshape(bsz, n, 2 * N_KV_HEADS, HEAD_DIM), 2, axis=2)
    return _rmsnorm(k, k_g), v


def _attend(q, k, v):
    bsz, n, _, _ = q.shape
    nb = n // Q_BLOCK
    qb = jnp.moveaxis(q.reshape(bsz, nb, Q_BLOCK, N_KV_HEADS, Q_PER_KV, HEAD_DIM), 1, 0)
    scale = HEAD_DIM ** -0.5

    def block(qi):
        s = jnp.einsum('bqkgd,bskd->bkgqs', qi, k).astype(jnp.float32) * scale
        p = jax.nn.softmax(s, axis=-1).astype(v.dtype)
        return jnp.einsum('bkgqs,bskd->bqkgd', p, v)

    o = lax.map(block, qb)
    return jnp.moveaxis(o, 0, 1).reshape(bsz, n, N_HEADS * HEAD_DIM)


def _attention_mixer(h_lat, h_ctx, w_qkv, q_g, k_g, w_out, with_ctx_out):
    w_q = w_qkv[:, :N_HEADS * HEAD_DIM]
    w_kv = w_qkv[:, N_HEADS * HEAD_DIM:]
    tables = _axial_tables(h_lat.shape[1])
    q_l = _axial_rope(_proj_q(h_lat, w_q, q_g), tables)
    k_l, v_l = _proj_kv(h_lat, w_kv, k_g)
    k_l = _axial_rope(k_l, tables)
    k_c, v_c = _proj_kv(h_ctx, w_kv, k_g)
    k_all = jnp.concatenate([k_l, k_c], axis=1)
    v_all = jnp.concatenate([v_l, v_c], axis=1)
    y_lat = _attend(q_l, k_all, v_all) @ w_out
    y_ctx = _attend(_proj_q(h_ctx, w_q, q_g), k_c, v_c) @ w_out if with_ctx_out else None
    return y_lat, y_ctx


def setup_inputs(seed: int = 0) -> dict:
    key = jax.random.key(seed)
    ks = jax.random.split(key, 21)
    f32 = jnp.float32
    nrm = lambda k, shape, s: jax.random.normal(k, shape, f32) * s
    D = D_MODEL
    return {
        "x": nrm(ks[0], (BATCH, SEQ, D), 1.0),
        "c": nrm(ks[1], (BATCH, D), 1.0),
        "ctx": nrm(ks[2], (BATCH, CTX_LEN, D), 1.0),
        "c_ctx": nrm(ks[3], (D,), 1.0),
        "ada_w": nrm(ks[4], (DEPTH, D, 6 * D), 0.5 * D ** -0.5),
        "ada_b": nrm(ks[5], (DEPTH, 6 * D), 0.01),
        "ln_g": 1.0 + nrm(ks[6], (DEPTH, 2, D), 0.05),
        "ln_b": nrm(ks[7], (DEPTH, 2, D), 0.01),
        "ffn_w_in": nrm(ks[8], (DEPTH, D, 2 * FFN_HIDDEN), D ** -0.5),
        "ffn_w_out": nrm(ks[9], (DEPTH, FFN_HIDDEN, D), BETA * FFN_HIDDEN ** -0.5),
        "mix_w_in": nrm(ks[10], (N_EVEN, D, MIX_IN), D ** -0.5),
        "conv_w": nrm(ks[11], (N_EVEN, CONV_TAPS, CONV_WIDTH), CONV_TAPS ** -0.5),
        "sgu_ln_g": 1.0 + nrm(ks[12], (N_EVEN, SGU_WIDTH), 0.05),
        "sgu_ln_b": nrm(ks[13], (N_EVEN, SGU_WIDTH), 0.01),
        "sgu_w": nrm(ks[14], (N_EVEN, SGU_GROUPS, CHUNK, CHUNK), CHUNK ** -0.5),
        "sgu_b": 1.0 + nrm(ks[15], (N_EVEN, SGU_GROUPS, CHUNK), 0.01),
        "mix_w_out": nrm(ks[16], (N_EVEN, MIX_OUT, D), BETA * MIX_OUT ** -0.5),
        "attn_w_qkv": nrm(ks[17], (N_ODD, D, (N_HEADS + 2 * N_KV_HEADS) * HEAD_DIM), D ** -0.5),
        "q_norm_g": 1.0 + nrm(ks[18], (N_ODD, HEAD_DIM), 0.05),
        "k_norm_g": 1.0 + nrm(ks[19], (N_ODD, HEAD_DIM), 0.05),
        "attn_w_out": nrm(ks[20], (N_ODD, N_HEADS * HEAD_DIM, D), BETA * (N_HEADS * HEAD_DIM) ** -0.5),
    }


def reference(x, c, ctx, c_ctx, ada_w, ada_b, ln_g, ln_b, ffn_w_in, ffn_w_out,
              mix_w_in, conv_w, sgu_ln_g, sgu_ln_b, sgu_w, sgu_b, mix_w_out,
              attn_w_qkv, q_norm_g, k_norm_g, attn_w_out):
    s_lat = jax.nn.silu(c)
    s_ctx = jax.nn.silu(c_ctx)
    for l in range(DEPTH):
        last = l == DEPTH - 1
        m_lat = jnp.split((s_lat @ ada_w[l] + ada_b[l])[:, None, :], 6, axis=-1)
        m_ctx = jnp.split(s_ctx @ ada_w[l] + ada_b[l], 6, axis=-1)
        h_lat = _modulate(x, m_lat[0], m_lat[1])
        h_ctx = _modulate(ctx, m_ctx[0], m_ctx[1])
        if l % 2 == 0:
            e = l // 2
            params = (mix_w_in[e], conv_w[e], sgu_ln_g[e], sgu_ln_b[e], sgu_w[e], sgu_b[e], mix_w_out[e])
            y_lat = _conv_chunk_mixer(h_lat, *params)
            y_ctx = None if last else _conv_chunk_mixer(h_ctx, *params)
        else:
            o = l // 2
            y_lat, y_ctx = _attention_mixer(h_lat, h_ctx, attn_w_qkv[o], q_norm_g[o], k_norm_g[o],
                                            attn_w_out[o], not last)
        x = _post_norm(x, y_lat, m_lat[2], ln_g[l, 0], ln_b[l, 0])
        x = _post_norm(x, _swiglu(_modulate(x, m_lat[3], m_lat[4]), ffn_w_in[l], ffn_w_out[l]),
                       m_lat[5], ln_g[l, 1], ln_b[l, 1])
        if not last:
            ctx = _post_norm(ctx, y_ctx, m_ctx[2], ln_g[l, 0], ln_b[l, 0])
            ctx = _post_norm(ctx, _swiglu(_modulate(ctx, m_ctx[3], m_ctx[4]), ffn_w_in[l], ffn_w_out[l]),
                             m_ctx[5], ln_g[l, 1], ln_b[l, 1])
    return x
```

```cpp
#include <hip/hip_runtime.h>
#include <hip/hip_cooperative_groups.h>
#include <cstdio>
#include <cstdint>
namespace cg = cooperative_groups;

namespace pg8 {
#define PG8_LAS __attribute__((address_space(3)))
typedef unsigned short bf16_t;
typedef short bf16x8 __attribute__((ext_vector_type(8)));
typedef float f32x4 __attribute__((ext_vector_type(4)));
typedef unsigned u32x4 __attribute__((ext_vector_type(4)));
constexpr int BM = 256, BK = 64, HALF = 128, HTB = HALF * BK * 2  , STAGE_BYTES = 8 * HTB, NXCD = 8, WGM = 8;

__host__ __device__ __forceinline__ int lds_byte(int r, int c) { const int st = (r >> 4) * 2 + (c >> 5), rr = r & 15, cc = c & 31, ob = rr * 64 + cc * 2; return st * 1024 + (ob ^ (((ob >> 9) & 1) << 5)); }
__host__ __device__ __forceinline__ void stage_rc(int b, int& R, int& C) { const int st = b / 1024, sb = b % 1024, swz = sb ^ (((sb >> 9) & 1) << 5); R = (st >> 1) * 16 + swz / 64; C = (st & 1) * 32 + (swz % 64) / 2; }
__host__ __device__ __forceinline__ int perm32(int rho) { const int n = rho >> 4, i = rho & 15; return 8 * (i >> 2) + 4 * n + (i & 3); }

struct Unit { int pm, pn; };
struct Gemm { const bf16_t* A; const bf16_t* Bt; int M, N, K; };

struct StaticOrder {
    int nM, nN, nwg, G, c;
    __host__ __device__ void init(int M, int N, int G_, int c_) { nM = M / BM; nN = N / BM; nwg = nM * nN; G = G_; c = c_; }
    __host__ __device__ bool next(int i, Unit& u) const {
        const long L = (long)i * G + c; if (L >= nwg) return false;
        int wgid = (int)L; { const int q = nwg / NXCD, r = nwg % NXCD, xcd = wgid % NXCD, off = wgid / NXCD; wgid = (xcd < r ? xcd * (q + 1) : r * (q + 1) + (xcd - r) * q) + off; }
        const int nig = WGM * nN, gid = wgid / nig, fm = gid * WGM, gsz = (nM - fm) < WGM ? (nM - fm) : WGM;
        u.pm = fm + ((wgid % nig) % gsz); u.pn = (wgid % nig) / gsz; return true;
    }
    __device__ __forceinline__ void a_ready(const Unit&) const {}
    __device__ __forceinline__ void done(const Unit&) const {}
};

__device__ __forceinline__ unsigned cvt_pk_bf16(float lo, float hi) { unsigned r; asm volatile("v_cvt_pk_bf16_f32 %0, %1, %2" : "=v"(r) : "v"(lo), "v"(hi)); return r; }
typedef float f32x2 __attribute__((ext_vector_type(2)));
__device__ __forceinline__ f32x2 gelu_pk(f32x2 v) {
    const f32x2 av = __builtin_elementwise_abs(v), d = av * 0.2316418882f + 1.0f;
    f32x2 t; t.x = __builtin_amdgcn_rcpf(d.x); t.y = __builtin_amdgcn_rcpf(d.y);
    f32x2 q = t * 0.5307027145f + (-0.7265760135f); q = q * t + 0.7107068705f; q = q * t + (-0.142248368f); q = q * t + 0.127414796f; q = q * t;
    const f32x2 s = (v * v) * (-0.72134752044f);
    f32x2 e; e.x = __builtin_amdgcn_exp2f(s.x); e.y = __builtin_amdgcn_exp2f(s.y);
    const f32x2 m = v * (q * e), r = v - m;
    f32x2 o; o.x = v.x < 0.f ? m.x : r.x; o.y = v.y < 0.f ? m.y : r.y; return o;
}

constexpr int DM = 1024;
constexpr float ALPHA_RES = 1.4142135623730951f;
__device__ __forceinline__ void st_bf8(bf16_t* p, f32x4 v0, f32x4 v1) {
    u32x4 w; w.x = cvt_pk_bf16(v0[0], v0[1]); w.y = cvt_pk_bf16(v0[2], v0[3]); w.z = cvt_pk_bf16(v1[0], v1[1]); w.w = cvt_pk_bf16(v1[2], v1[3]);
    *(u32x4*)p = w;
}
__device__ __forceinline__ f32x4 gelu4(f32x4 v) { f32x2 a = gelu_pk((f32x2){v[0], v[1]}), b = gelu_pk((f32x2){v[2], v[3]}); return (f32x4){a.x, a.y, b.x, b.y}; }
__device__ __forceinline__ float silu1(float g) { return g * __builtin_amdgcn_rcpf(1.0f + __builtin_amdgcn_exp2f(-1.4426950408889634f * g)); }
__device__ __forceinline__ f32x4 swiglu4(f32x4 g, f32x4 u) { return (f32x4){silu1(g[0]) * u[0], silu1(g[1]) * u[1], silu1(g[2]) * u[2], silu1(g[3]) * u[3]}; }

struct EpiMixIn {
    static constexpr bool PERM = true, AFTER_DRAIN = false;
    bf16_t* P;
    __device__ __forceinline__ void operator()(const f32x4 (&acc)[2][2][4][2], const Unit& u, int wr, int wc, int fr, int fq) const {
        const int row0 = u.pm * BM + wr * 64 + fr, cw = wc * 32 + 8 * fq;
        if (u.pn < 2) {
#pragma unroll
            for (int ai = 0; ai < 2; ++ai)
#pragma unroll
                for (int m = 0; m < 4; ++m) { bf16_t* rowp = P + (size_t)(row0 + ai * HALF + m * 16) * 2048 + u.pn * 256 + cw;
#pragma unroll
                    for (int bj = 0; bj < 2; ++bj) st_bf8(rowp + bj * HALF, acc[ai][bj][m][0], acc[ai][bj][m][1]); }
        } else if (u.pn < 6) {
#pragma unroll
            for (int ai = 0; ai < 2; ++ai)
#pragma unroll
                for (int m = 0; m < 4; ++m) { bf16_t* rowp = P + (size_t)(row0 + ai * HALF + m * 16) * 2048 + 512 + (u.pn - 2) * 128 + cw;
                    st_bf8(rowp, acc[ai][0][m][0] * acc[ai][1][m][0], acc[ai][0][m][1] * acc[ai][1][m][1]); }
        } else {
#pragma unroll
            for (int ai = 0; ai < 2; ++ai)
#pragma unroll
                for (int m = 0; m < 4; ++m) { bf16_t* rowp = P + (size_t)(row0 + ai * HALF + m * 16) * 2048 + 1024 + (u.pn - 6) * 256 + cw;
#pragma unroll
                    for (int bj = 0; bj < 2; ++bj) st_bf8(rowp + bj * HALF, gelu4(acc[ai][bj][m][0]), gelu4(acc[ai][bj][m][1])); }
        }
    }
};
struct EpiSwiglu {
    static constexpr bool PERM = true, AFTER_DRAIN = false;
    bf16_t* H;
    __device__ __forceinline__ void operator()(const f32x4 (&acc)[2][2][4][2], const Unit& u, int wr, int wc, int fr, int fq) const {
        const int row0 = u.pm * BM + wr * 64 + fr, cw = wc * 32 + 8 * fq;
#pragma unroll
        for (int ai = 0; ai < 2; ++ai)
#pragma unroll
            for (int m = 0; m < 4; ++m) { bf16_t* rowp = H + (size_t)(row0 + ai * HALF + m * 16) * 2816 + u.pn * 128 + cw;
                st_bf8(rowp, swiglu4(acc[ai][0][m][0], acc[ai][1][m][0]), swiglu4(acc[ai][0][m][1], acc[ai][1][m][1])); }
    }
};
struct EpiResid {
    static constexpr bool PERM = false, AFTER_DRAIN = false;
    const float* src_lat; const float* src_ctx; float* dst; const float* gate;
    __device__ __forceinline__ void operator()(const f32x4 (&acc)[2][2][4][2], const Unit& u, int wr, int wc, int fr, int fq) const {
        const int bb = u.pm < 256 ? (u.pm >> 3) : 32;
        const int col0 = u.pn * BM + wc * 32 + 4 * fq, r_in = wr * 64 + fr;
        const float* gp = gate + (size_t)bb * 6144 + col0;
        const float* sbase = (u.pm < 256 ? src_lat + (size_t)u.pm * BM * DM : src_ctx + (size_t)(u.pm - 256) * BM * DM) + (size_t)r_in * DM + col0;
        float* dbase = dst + (size_t)u.pm * BM * DM + (size_t)r_in * DM + col0;
#pragma unroll
        for (int bj = 0; bj < 2; ++bj)
#pragma unroll
            for (int n = 0; n < 2; ++n) { const f32x4 gv = *(const f32x4*)(gp + bj * HALF + n * 16);
#pragma unroll
                for (int ai = 0; ai < 2; ++ai) {
#pragma unroll
                    for (int m = 0; m < 4; ++m) { const int off = (ai * HALF + m * 16) * DM + bj * HALF + n * 16; const f32x4 sv = *(const f32x4*)(sbase + off);
                        *(f32x4*)(dbase + off) = sv * ALPHA_RES + gv * acc[ai][bj][m][n]; }
                    asm volatile("" ::: "memory"); } }
    }
};
struct QkvOrder : StaticOrder {
    __device__ bool next(int i, Unit& u) const {
        const long L = (long)i * G + c;
        if (L < nwg) return StaticOrder::next(i, u);
        const int j = (int)(L - nwg); if (j >= 64) return false;
        u.pm = 256 + (j & 31); u.pn = 4 + (j >> 5); return true;
    }
};
struct EpiQKV {
    static constexpr bool PERM = true, AFTER_DRAIN = false;
    bf16_t* Q; bf16_t* Kb; bf16_t* Vb;
    __device__ __forceinline__ void operator()(const f32x4 (&acc)[2][2][4][2], const Unit& u, int wr, int wc, int fr, int fq) const {
        const int cw = wc * 32 + 8 * fq, r_in = wr * 64 + fr;
        constexpr int pn_k = 4; const bool is_ctx = u.pm >= 256;
        if (u.pn < pn_k) {
#pragma unroll
            for (int ai = 0; ai < 2; ++ai)
#pragma unroll
                for (int m = 0; m < 4; ++m) { bf16_t* rowp = Q + (size_t)(u.pm * BM + r_in + ai * HALF + m * 16) * 1024 + u.pn * 256 + cw;
#pragma unroll
                    for (int bj = 0; bj < 2; ++bj) st_bf8(rowp + bj * HALF, acc[ai][bj][m][0], acc[ai][bj][m][1]); }
        } else {
            bf16_t* base = (u.pn == pn_k) ? Kb : Vb;
            const size_t kvrow0 = is_ctx ? (size_t)(u.pm - 256) * 2304 + 2048 : (size_t)(u.pm >> 3) * 2304 + (size_t)(u.pm & 7) * 256;
#pragma unroll
            for (int ai = 0; ai < 2; ++ai)
#pragma unroll
                for (int m = 0; m < 4; ++m) { bf16_t* rowp = base + (kvrow0 + r_in + ai * HALF + m * 16) * 256 + cw;
#pragma unroll
                    for (int bj = 0; bj < 2; ++bj) st_bf8(rowp + bj * HALF, acc[ai][bj][m][0], acc[ai][bj][m][1]); }
        }
    }
};

template <class Epi, class Sched, bool ALIGN_EPI = false, bool SP2 = false>
__device__ __forceinline__ void gemm_phase(PG8_LAS unsigned char* lds, const Gemm g, const Sched& S, const Epi& E) {
    int tid_ = threadIdx.x; asm volatile("" : "+v"(tid_));
    const int tid = tid_, wid = __builtin_amdgcn_readfirstlane(tid >> 6), lane = tid & 63, wr = wid >> 2, wc = wid & 3, fr = lane & 15, fq = lane >> 4;
    const int K = g.K, nt = K / BK;
    unsigned voffA[2], voffB[2];
#pragma unroll
    for (int i = 0; i < 2; ++i) { int R, C; stage_rc(tid * 16 + i * 8192, R, C); const int Rb = Epi::PERM ? ((R & ~31) + perm32(R & 31)) : R;
        voffA[i] = (unsigned)(R * K + C) * 2u; voffB[i] = (unsigned)(Rb * K + C) * 2u; }
    const size_t kstep = (size_t)(BK * 2);
    const size_t hstep = (size_t)HALF * K * 2;
    const size_t tstep = 2 * hstep;
    const unsigned ldsw = (unsigned)wid * 1024u;
    const int aoff = lds_byte(wr * 64 + fr, fq * 8), boff = lds_byte(wc * 32 + fr, fq * 8);
#define PG8_SA(b, h) (((b) * 2 + (h)) * HTB)
#define PG8_SB(b, h) ((4 + (b) * 2 + (h)) * HTB)
#define PG8_STAGE(bufoff, gbase, voff) do { _Pragma("unroll") for (int _i = 0; _i < 2; ++_i) \
        __builtin_amdgcn_global_load_lds((const unsigned*)((const char*)(gbase) + (voff)[_i]), (PG8_LAS unsigned*)(lds + (bufoff) + ldsw + _i * 8192), 16, 0, 0); } while (0)
#define PG8_LDA(dst, b, h) do { _Pragma("unroll") for (int m = 0; m < 4; ++m) _Pragma("unroll") for (int k = 0; k < 2; ++k) dst[m][k] = *(const PG8_LAS bf16x8*)(lds + PG8_SA(b, h) + aoff + m * 2048 + k * 1024); } while (0)
#define PG8_LDB(dst, b, h) do { _Pragma("unroll") for (int n = 0; n < 2; ++n) _Pragma("unroll") for (int k = 0; k < 2; ++k) dst[n][k] = *(const PG8_LAS bf16x8*)(lds + PG8_SB(b, h) + boff + n * 2048 + k * 1024); } while (0)
#define PG8_MMA(ai, bj, At, Bt) do { __builtin_amdgcn_s_setprio(1); _Pragma("unroll") for (int m = 0; m < 4; ++m) _Pragma("unroll") for (int n = 0; n < 2; ++n) _Pragma("unroll") for (int k = 0; k < 2; ++k) \
        acc[ai][bj][m][n] = __builtin_amdgcn_mfma_f32_16x16x32_bf16(Bt[n][k], At[m][k], acc[ai][bj][m][n], 0, 0, 0); __builtin_amdgcn_s_setprio(0); } while (0)
#define PG8_WAIT_V(n) asm volatile("s_waitcnt vmcnt(" #n ")" ::: "memory")
#define PG8_WAIT_L(n) asm volatile("s_waitcnt lgkmcnt(" #n ")" ::: "memory")
#define PG8_BAR __builtin_amdgcn_s_barrier()
#define PG8_SCHED __builtin_amdgcn_sched_barrier(0)
    Unit cur, nxt; int ui = 0;
    if (!S.next(0, cur)) return;
    f32x4 acc[2][2][4][2];
#pragma unroll
    for (int a = 0; a < 2; ++a)
#pragma unroll
        for (int b = 0; b < 2; ++b)
#pragma unroll
            for (int m = 0; m < 4; ++m)
#pragma unroll
                for (int n = 0; n < 2; ++n) acc[a][b][m][n] = (f32x4){0.f, 0.f, 0.f, 0.f};
    bf16x8 At[4][2], B0[2][2], B1[2][2];
    const char* cA = (const char*)g.A + (size_t)cur.pm * tstep; const char* cB = (const char*)g.Bt + (size_t)cur.pn * tstep;
    S.a_ready(cur);
    if constexpr (SP2) {
        PG8_STAGE(PG8_SB(0, 0), cB, voffB); PG8_STAGE(PG8_SB(0, 1), cB + hstep, voffB); PG8_STAGE(PG8_SA(0, 0), cA, voffA); PG8_STAGE(PG8_SA(0, 1), cA + hstep, voffA);
        if (wr == 1) PG8_BAR;
        PG8_WAIT_V(2); PG8_BAR;
        PG8_STAGE(PG8_SB(1, 0), cB + kstep, voffB); PG8_STAGE(PG8_SA(1, 0), cA + kstep, voffA); PG8_STAGE(PG8_SB(1, 1), cB + hstep + kstep, voffB);
        PG8_WAIT_V(6); PG8_BAR;
    } else {
        PG8_STAGE(PG8_SB(0, 0), cB, voffB); PG8_STAGE(PG8_SA(0, 0), cA, voffA); PG8_STAGE(PG8_SB(0, 1), cB + hstep, voffB); PG8_STAGE(PG8_SA(0, 1), cA + hstep, voffA);
        if (wr == 1) PG8_BAR;
        PG8_WAIT_V(4); PG8_BAR;
        PG8_STAGE(PG8_SB(1, 0), cB + kstep, voffB); PG8_STAGE(PG8_SA(1, 0), cA + kstep, voffA); PG8_STAGE(PG8_SB(1, 1), cB + hstep + kstep, voffB);
        PG8_WAIT_V(6); PG8_BAR;
    }
    for (;;) {
        const bool has_next = S.next(ui + 1, nxt);
        const char* nA = has_next ? (const char*)g.A + (size_t)nxt.pm * tstep : cA; const char* nB = has_next ? (const char*)g.Bt + (size_t)nxt.pn * tstep : cB;
        for (int t = 0; t < nt; t += 2) {
            const bool last = (t == nt - 2);
            const char* a1 = cA + (size_t)(t + 1) * kstep;
            const char* a2 = last ? nA : cA + (size_t)(t + 2) * kstep; const char* b2 = last ? nB : cB + (size_t)(t + 2) * kstep;
            const char* a3 = a2 + kstep; const char* b3 = b2 + kstep;
            if (last && has_next) S.a_ready(nxt);
            if constexpr (SP2) {
            PG8_LDB(B0, 0, 0); PG8_LDB(B1, 0, 1); PG8_SCHED; PG8_LDA(At, 0, 0); PG8_STAGE(PG8_SA(1, 1), a1 + hstep, voffA);
            PG8_WAIT_V(8); PG8_WAIT_L(0); PG8_BAR; PG8_MMA(0, 0, At, B0); PG8_MMA(0, 1, At, B1); PG8_BAR; PG8_SCHED;
            PG8_LDA(At, 0, 1); PG8_STAGE(PG8_SB(0, 0), b2, voffB); PG8_STAGE(PG8_SB(0, 1), b2 + hstep, voffB); PG8_STAGE(PG8_SA(0, 0), a2, voffA);
            PG8_WAIT_V(8); PG8_WAIT_L(0); PG8_BAR; PG8_MMA(1, 0, At, B0); PG8_MMA(1, 1, At, B1); PG8_BAR; PG8_SCHED;
            PG8_LDB(B0, 1, 0); PG8_LDB(B1, 1, 1); PG8_SCHED; PG8_LDA(At, 1, 0); PG8_STAGE(PG8_SA(0, 1), a2 + hstep, voffA);
            PG8_WAIT_V(8); PG8_WAIT_L(0); PG8_BAR; PG8_MMA(0, 0, At, B0); PG8_MMA(0, 1, At, B1); PG8_BAR; PG8_SCHED;
            PG8_LDA(At, 1, 1); PG8_STAGE(PG8_SB(1, 0), b3, voffB); PG8_STAGE(PG8_SB(1, 1), b3 + hstep, voffB); PG8_STAGE(PG8_SA(1, 0), a3, voffA);
            PG8_WAIT_V(8); PG8_WAIT_L(0); PG8_BAR; PG8_MMA(1, 0, At, B0); PG8_MMA(1, 1, At, B1); PG8_BAR; PG8_SCHED;
            } else {
            PG8_LDB(B0, 0, 0); PG8_SCHED; PG8_LDA(At, 0, 0); PG8_STAGE(PG8_SA(1, 1), a1 + hstep, voffA);
            PG8_WAIT_L(8); PG8_BAR; PG8_WAIT_L(0); PG8_MMA(0, 0, At, B0); PG8_BAR; PG8_SCHED;
            PG8_LDB(B1, 0, 1); PG8_STAGE(PG8_SB(0, 0), b2, voffB);
            PG8_BAR; PG8_WAIT_L(0); PG8_MMA(0, 1, At, B1); PG8_BAR;
            PG8_LDA(At, 0, 1); PG8_STAGE(PG8_SA(0, 0), a2, voffA);
            PG8_BAR; PG8_WAIT_L(0); PG8_MMA(1, 0, At, B0); PG8_BAR; PG8_SCHED;
            PG8_STAGE(PG8_SB(0, 1), b2 + hstep, voffB);
            PG8_WAIT_V(6); PG8_BAR; PG8_MMA(1, 1, At, B1); PG8_BAR;
            PG8_LDB(B0, 1, 0); PG8_SCHED; PG8_LDA(At, 1, 0); PG8_STAGE(PG8_SA(0, 1), a2 + hstep, voffA);
            PG8_WAIT_L(8); PG8_BAR; PG8_WAIT_L(0); PG8_MMA(0, 0, At, B0); PG8_BAR; PG8_SCHED;
            PG8_LDB(B1, 1, 1); PG8_STAGE(PG8_SB(1, 0), b3, voffB);
            PG8_BAR; PG8_WAIT_L(0); PG8_MMA(0, 1, At, B1); PG8_BAR;
            PG8_LDA(At, 1, 1); PG8_STAGE(PG8_SA(1, 0), a3, voffA);
            PG8_BAR; PG8_WAIT_L(0); PG8_MMA(1, 0, At, B0); PG8_BAR; PG8_SCHED;
            PG8_STAGE(PG8_SB(1, 1), b3 + hstep, voffB);
            PG8_WAIT_V(6); PG8_BAR; PG8_MMA(1, 1, At, B1); PG8_BAR;
            }
        }
        if constexpr (ALIGN_EPI) { if (wr == 0) PG8_BAR; }
        if constexpr (!Epi::AFTER_DRAIN) { E(acc, cur, wr, wc, fr, fq); S.done(cur); }
        if (!has_next) break;
#pragma unroll
        for (int a = 0; a < 2; ++a)
#pragma unroll
            for (int b = 0; b < 2; ++b)
#pragma unroll
                for (int m = 0; m < 4; ++m)
#pragma unroll
                    for (int n = 0; n < 2; ++n) acc[a][b][m][n] = (f32x4){0.f, 0.f, 0.f, 0.f};
        cur = nxt; cA = nA; cB = nB; ++ui;
        if constexpr (ALIGN_EPI) { if (wr == 1) PG8_BAR; }
    }
    PG8_WAIT_V(0);
    if constexpr (!ALIGN_EPI) { if (wr == 0) PG8_BAR; }
    PG8_BAR;
    if constexpr (Epi::AFTER_DRAIN) { E.fused(acc, cur, wr, wc, fr, fq, lds, wid, lane); S.done(cur); }
#undef PG8_SA
#undef PG8_SB
#undef PG8_STAGE
#undef PG8_LDA
#undef PG8_LDB
#undef PG8_MMA
#undef PG8_WAIT_V
#undef PG8_WAIT_L
#undef PG8_BAR
#undef PG8_SCHED
}
}

namespace att {
typedef unsigned short bf16;
constexpr int   D = 128, NW = 8, QBLK = 32, KVBLK = 64;
constexpr float SCALE = 0.088388347648318440f;
constexpr float THR = 8.f;
constexpr int SDEPTH = 2;
constexpr int LDQ = 1024, LDK = 256, LDO = 1024;
constexpr size_t SHM_V = KVBLK * D * 2, SHM_K = KVBLK * D * 2, SHM_ATTN = 2 * SHM_V + 2 * SHM_K + NW * 64 * 4;
using bf16x8 = __attribute__((ext_vector_type(8))) short;
using s16x4  = __attribute__((ext_vector_type(4))) short;
using f32x16 = __attribute__((ext_vector_type(16))) float;
using f32x8  = __attribute__((ext_vector_type(8))) float;
using u32x4  = __attribute__((ext_vector_type(4))) unsigned;
#define KSWZ(row, colB) ((row) * 256 + ((colB) ^ (((row) & 7) << 4)))
#define SBAR() __builtin_amdgcn_sched_barrier(0)
__device__ __forceinline__ int crow(int r, int hi) { return (r & 3) + 8 * (r >> 2) + 4 * hi; }
__device__ __forceinline__ unsigned cvtpk(float lo, float hi) {
  unsigned r; asm volatile("v_cvt_pk_bf16_f32 %0, %1, %2" : "=v"(r) : "v"(lo), "v"(hi)); return r;
}
template <typename TIn> struct Stage;
template <> struct Stage<bf16>  { using T = bf16x8;
  __device__ static __forceinline__ T ld8(const bf16* p) { return *reinterpret_cast<const bf16x8*>(p); }
  __device__ static __forceinline__ bf16x8 tobf(T x) { return x; } };
template <> struct Stage<float> { using T = f32x8;
  __device__ static __forceinline__ T ld8(const float* p) { return *reinterpret_cast<const f32x8*>(p); }
  __device__ static __forceinline__ bf16x8 tobf(T x) {
    u32x4 w = {cvtpk(x[0], x[1]), cvtpk(x[2], x[3]), cvtpk(x[4], x[5]), cvtpk(x[6], x[7])}; return *reinterpret_cast<bf16x8*>(&w); } };

__device__ __forceinline__ void partialSM(f32x16& p0, f32x16& p1, float& m_reg, float& mn, float& alpha) {
  constexpr float C = SCALE * 1.4426950408889634f;
  float pmax = p0[0]; for (int r = 1; r < 16; ++r) pmax = fmaxf(pmax, p0[r]); for (int r = 0; r < 16; ++r) pmax = fmaxf(pmax, p1[r]);
  { auto rr = __builtin_amdgcn_permlane32_swap(__float_as_uint(pmax), __float_as_uint(pmax), false, false);
    pmax = fmaxf(__uint_as_float(rr[0]), __uint_as_float(rr[1])); }
  if (__builtin_expect(__all(pmax - m_reg <= THR / SCALE), 1)) { mn = m_reg; alpha = 1.f; }
  else { mn = fmaxf(m_reg, pmax); alpha = __builtin_amdgcn_exp2f((m_reg - mn) * C); m_reg = mn; }
  float mnC = -mn * C;
  for (int r = 0; r < 16; ++r) p0[r] = fmaf(p0[r], C, mnC); for (int r = 0; r < 16; ++r) p1[r] = fmaf(p1[r], C, mnC);
  for (int r = 0; r < 16; ++r) p0[r] = __builtin_amdgcn_exp2f(p0[r]);
}
__device__ __forceinline__ void finishSM(f32x16& p0, f32x16& p1, float alpha, float& l_reg, bf16x8& pa0, bf16x8& pa1, bf16x8& pa2, bf16x8& pa3) {
  for (int r = 0; r < 16; ++r) p1[r] = __builtin_amdgcn_exp2f(p1[r]);
  float ps = 0; for (int r = 0; r < 16; ++r) ps += p0[r]; for (int r = 0; r < 16; ++r) ps += p1[r];
  { auto rr = __builtin_amdgcn_permlane32_swap(__float_as_uint(ps), __float_as_uint(ps), false, false);
    ps = __uint_as_float(rr[0]) + __uint_as_float(rr[1]); }
  l_reg = l_reg * alpha + ps;
#define PK4(P, BASE, OUT) do { unsigned a0 = cvtpk(P[BASE + 0], P[BASE + 1]), a1 = cvtpk(P[BASE + 2], P[BASE + 3]);   \
    unsigned b0 = cvtpk(P[BASE + 4], P[BASE + 5]), b1 = cvtpk(P[BASE + 6], P[BASE + 7]);                              \
    auto r0 = __builtin_amdgcn_permlane32_swap(a0, b0, false, false); auto r1 = __builtin_amdgcn_permlane32_swap(a1, b1, false, false); \
    u32x4 w = {r0[0], r1[0], r0[1], r1[1]}; OUT = *reinterpret_cast<bf16x8*>(&w); } while (0)
  PK4(p0, 0, pa0); PK4(p0, 8, pa1); PK4(p1, 0, pa2); PK4(p1, 8, pa3);
#undef PK4
}
__device__ __forceinline__ void qkt(f32x16& p0, f32x16& p1, const bf16* Ks, const bf16x8* qr, int r32, int hi) {
  p0 = f32x16{}; p1 = f32x16{};
  for (int d0 = 0; d0 < 8; ++d0) { int cb = (d0 * 16 + hi * 8) * 2;
    bf16x8 b0 = *reinterpret_cast<const bf16x8*>((const char*)Ks + KSWZ(r32, cb));
    bf16x8 b1 = *reinterpret_cast<const bf16x8*>((const char*)Ks + KSWZ(32 + r32, cb));
    p0 = __builtin_amdgcn_mfma_f32_32x32x16_bf16(b0, qr[d0], p0, 0, 0, 0);
    p1 = __builtin_amdgcn_mfma_f32_32x32x16_bf16(b1, qr[d0], p1, 0, 0, 0); }
}
__device__ __forceinline__ int v_st(int k, int c) { const int kk = (k & ~0xC) | ((k & 4) << 1) | ((k & 8) >> 1); return ((kk >> 3) * 4 + (c >> 5)) * 512 + ((kk & 7) * 32 + (c & 31)) * 2; }
__device__ __forceinline__ int v_rd_base(int lane) { return ((lane & 3) << 3) | (((lane >> 2) & 3) << 6) | (((lane >> 4) & 1) << 5) | (((lane >> 5) & 1) << 8); }
constexpr int v_rd_off(int d0, int ks, int half) { return d0 * 512 + ks * 4096 + half * 2048; }
template <int OFF> __device__ __forceinline__ s16x4 tr_read(int vb) {
  s16x4 r; asm volatile("ds_read_b64_tr_b16 %0, %1 offset:%2" : "=&v"(r) : "v"(vb), "i"(OFF) : "memory"); return r;
}
template <int D0> __device__ __forceinline__ void pv_one(f32x16& od, int vb, bf16x8 pa0, bf16x8 pa1, bf16x8 pa2, bf16x8 pa3) {
  const s16x4 l0 = tr_read<v_rd_off(D0, 0, 0)>(vb), h0 = tr_read<v_rd_off(D0, 0, 1)>(vb), l1 = tr_read<v_rd_off(D0, 1, 0)>(vb), h1 = tr_read<v_rd_off(D0, 1, 1)>(vb);
  const s16x4 l2 = tr_read<v_rd_off(D0, 2, 0)>(vb), h2 = tr_read<v_rd_off(D0, 2, 1)>(vb), l3 = tr_read<v_rd_off(D0, 3, 0)>(vb), h3 = tr_read<v_rd_off(D0, 3, 1)>(vb);
  asm volatile("s_waitcnt lgkmcnt(0)" ::: "memory"); SBAR();
#define PK(L, H) (bf16x8){L[0], L[1], L[2], L[3], H[0], H[1], H[2], H[3]}
  od = __builtin_amdgcn_mfma_f32_32x32x16_bf16(pa0, PK(l0, h0), od, 0, 0, 0);
  od = __builtin_amdgcn_mfma_f32_32x32x16_bf16(pa1, PK(l1, h1), od, 0, 0, 0);
  od = __builtin_amdgcn_mfma_f32_32x32x16_bf16(pa2, PK(l2, h2), od, 0, 0, 0);
  od = __builtin_amdgcn_mfma_f32_32x32x16_bf16(pa3, PK(l3, h3), od, 0, 0, 0);
#undef PK
}
__device__ __forceinline__ void pv_d0(f32x16* o, int vb, bf16x8 pa0, bf16x8 pa1, bf16x8 pa2, bf16x8 pa3) {
  pv_one<0>(o[0], vb, pa0, pa1, pa2, pa3); pv_one<1>(o[1], vb, pa0, pa1, pa2, pa3); pv_one<2>(o[2], vb, pa0, pa1, pa2, pa3); pv_one<3>(o[3], vb, pa0, pa1, pa2, pa3);
}

template <typename TQ>
__device__ __forceinline__ void attn_dense_body(const TQ* __restrict__ Qb, const bf16* __restrict__ Kh, const bf16* __restrict__ Vh,
                                                bf16* __restrict__ Ob, int seq, char* lds) {
  using St = Stage<bf16>; using SQ = Stage<TQ>;
  int tid_ = threadIdx.x; asm volatile("" : "+v"(tid_));
  const int tid = tid_, wid = tid >> 6, lane = tid & 63, r32 = lane & 31, hi = lane >> 5;
  bf16* V_lds = (bf16*)lds; bf16* K_lds = (bf16*)(lds + 2 * SHM_V);
  float* ws = (float*)(lds + 2 * SHM_V + 2 * SHM_K) + wid * 64; float* li_l = ws; float* al_l = ws + 32;
  float m_reg = -1e30f, l_reg = 0; f32x16 o[4] = {}; bf16x8 qr[8];
  const TQ* Qw = Qb + (long)(wid * QBLK + r32) * LDQ + hi * 8;
#pragma unroll
  for (int d0 = 0; d0 < 8; ++d0) qr[d0] = SQ::tobf(SQ::ld8(Qw + d0 * 16));
  const int sr = tid >> 4, sc = (tid & 15) * 8, vst0 = v_st(sr, sc), vst1 = v_st(32 + sr, sc);
  const int vb0 = (int)(uintptr_t)V_lds + v_rd_base(lane);
  struct { typename St::T vs0, vs1, ks0, ks1; } sr_[SDEPTH];
#define SLOAD(i, k0) do { sr_[i].vs0 = St::ld8(&Vh[(long)((k0) + sr) * LDK + sc]); sr_[i].vs1 = St::ld8(&Vh[(long)((k0) + 32 + sr) * LDK + sc]); \
    sr_[i].ks0 = St::ld8(&Kh[(long)((k0) + sr) * LDK + sc]); sr_[i].ks1 = St::ld8(&Kh[(long)((k0) + 32 + sr) * LDK + sc]); } while (0)
#define SWRITE(b, i) do { *(bf16x8*)((char*)V_lds + (b) * SHM_V + vst0) = St::tobf(sr_[i].vs0);          \
    *(bf16x8*)((char*)V_lds + (b) * SHM_V + vst1) = St::tobf(sr_[i].vs1); int kc = sc * 2;               \
    *(bf16x8*)((char*)K_lds + (b) * SHM_K + KSWZ(sr, kc)) = St::tobf(sr_[i].ks0);                       \
    *(bf16x8*)((char*)K_lds + (b) * SHM_K + KSWZ(32 + sr, kc)) = St::tobf(sr_[i].ks1); } while (0)
#define SWAIT() do { if constexpr (SDEPTH == 2) asm volatile("s_waitcnt vmcnt(4)" ::: "memory"); else asm volatile("s_waitcnt vmcnt(0)" ::: "memory"); } while (0)
#define RESC(a) do { if (__any((a) < 1.f)) { if (hi == 0) al_l[r32] = (a); asm volatile("s_waitcnt lgkmcnt(0)" ::: "memory"); \
    for (int d = 0; d < 4; ++d) for (int r = 0; r < 16; ++r) o[d][r] *= al_l[crow(r, hi)]; } } while (0)
  f32x16 pA0, pA1, pB0, pB1; float mnA, mnB, alA, alB; bf16x8 pa0, pa1, pa2, pa3; const int NT = seq / KVBLK;
  constexpr int SE = 0, SO = SDEPTH - 1;
  SLOAD(SE, 0); asm volatile("s_waitcnt vmcnt(0)" ::: "memory"); SWRITE(0, SE); __syncthreads();
  qkt(pA0, pA1, K_lds, qr, r32, hi); partialSM(pA0, pA1, m_reg, mnA, alA);
  SLOAD(SO, KVBLK); if constexpr (SDEPTH == 2) { if (2 < NT) SLOAD(SE, 2 * KVBLK); }
  SWAIT(); SWRITE(1, SO); __syncthreads();
  for (int j = 1; j + 1 < NT; j += 2) {
    SBAR(); qkt(pB0, pB1, (bf16*)((char*)K_lds + SHM_K), qr, r32, hi);
    finishSM(pA0, pA1, alA, l_reg, pa0, pa1, pa2, pa3); SBAR();
    SLOAD(SO, (j + SDEPTH) * KVBLK); SBAR();
    pv_d0(o, vb0, pa0, pa1, pa2, pa3); partialSM(pB0, pB1, m_reg, mnB, alB);
    __syncthreads(); SWAIT(); SWRITE(0, SE);
    RESC(alB); __syncthreads();
    SBAR(); qkt(pA0, pA1, K_lds, qr, r32, hi);
    finishSM(pB0, pB1, alB, l_reg, pa0, pa1, pa2, pa3); SBAR();
    if (SDEPTH == 1 || j + 3 < NT) SLOAD(SE, (j + 1 + SDEPTH) * KVBLK); SBAR();
    pv_d0(o, vb0 + (int)SHM_V, pa0, pa1, pa2, pa3); partialSM(pA0, pA1, m_reg, mnA, alA);
    __syncthreads(); SWAIT(); SWRITE(1, SO);
    RESC(alA); __syncthreads();
  }
  SBAR(); qkt(pB0, pB1, (bf16*)((char*)K_lds + SHM_K), qr, r32, hi);
  finishSM(pA0, pA1, alA, l_reg, pa0, pa1, pa2, pa3); SBAR();
  pv_d0(o, vb0, pa0, pa1, pa2, pa3); partialSM(pB0, pB1, m_reg, mnB, alB);
  __syncthreads(); RESC(alB);
  finishSM(pB0, pB1, alB, l_reg, pa0, pa1, pa2, pa3); SBAR();
  pv_d0(o, vb0 + (int)SHM_V, pa0, pa1, pa2, pa3);
  if (hi == 0) li_l[r32] = l_reg; asm volatile("s_waitcnt lgkmcnt(0)" ::: "memory");
  float rli[16];
#pragma unroll
  for (int r = 0; r < 16; ++r) rli[r] = __builtin_amdgcn_rcpf(li_l[crow(r, hi)]);
  bf16* Ow = Ob + (long)(wid * QBLK) * LDO;
#pragma unroll
  for (int r = 0; r < 16; ++r) { int orow = crow(r, hi);
    for (int d0 = 0; d0 < 4; ++d0) Ow[(long)orow * LDO + d0 * 32 + r32] = (bf16)(cvtpk(o[d0][r] * rli[r], 0.f) & 0xffffu); }
#undef SLOAD
#undef SWRITE
#undef SWAIT
#undef RESC
}
}

#define LAS __attribute__((address_space(3)))
typedef unsigned short bf16;
typedef float f32x4 __attribute__((ext_vector_type(4)));
typedef unsigned v4u __attribute__((ext_vector_type(4)));
typedef unsigned v2u __attribute__((ext_vector_type(2)));
typedef short bf16x8 __attribute__((ext_vector_type(8)));

constexpr int NWAVES = 8, NTHR = 512;
constexpr int DM = 1024, NB = 32, SEQ = 2048, CTXL = 256, NLAT = NB * SEQ, NCTX = NB * CTXL, MT = NLAT + NCTX, FF = 2816, MIXIN = 2560, NQKV = 1536, SKV = SEQ + CTXL;
constexpr float LN_EPS = 1e-5f, RMS_EPS = 1e-6f;
constexpr size_t MiB = 1u << 20;
constexpr size_t WS_MOD = 1 * MiB, WS_ROPE = 3 * MiB, WS_WSGU = 4 * MiB, WS_WMIXIN = 5 * MiB, WS_WMIXOUT = 10 * MiB, WS_WFFNIN = 12 * MiB, WS_WFFNOUT = 34 * MiB,
                 WS_WQKV = 45 * MiB, WS_WAOUT = 48 * MiB, WS_STREAM = 50 * MiB, WS_H = 338 * MiB, WS_BIG = 482 * MiB, WS_END = 878 * MiB;
constexpr size_t BIG_K = 128 * MiB, BIG_V = 164 * MiB, BIG_O = 200 * MiB;
static_assert(WS_STREAM + (size_t)MT * DM * 4 <= WS_H && WS_H + (size_t)MT * DM * 2 <= WS_BIG && WS_BIG + (size_t)MT * FF * 2 <= WS_END, "ws map");
static_assert((size_t)NLAT * DM * 2 <= BIG_K && BIG_K + (size_t)NB * SKV * 256 * 2 <= BIG_V && BIG_V + (size_t)NB * SKV * 256 * 2 <= BIG_O, "ws map 2");
constexpr int LDS_BYTES = 147456;
constexpr int NPH = 17;

__device__ __forceinline__ float wave_sum(float v) {
#pragma unroll
    for (int o = 1; o < 64; o <<= 1) v += __shfl_xor(v, o);
    return v;
}
__device__ __forceinline__ unsigned pk2(float lo, float hi) { unsigned r; asm volatile("v_cvt_pk_bf16_f32 %0, %1, %2" : "=v"(r) : "v"(lo), "v"(hi)); return r; }
__device__ __forceinline__ float bflo(unsigned u) { return __uint_as_float(u << 16); }
__device__ __forceinline__ float bfhi(unsigned u) { return __uint_as_float(u & 0xffff0000u); }
__device__ __forceinline__ void unpack8(v4u r, float (&x)[8]) { x[0] = bflo(r.x); x[1] = bfhi(r.x); x[2] = bflo(r.y); x[3] = bfhi(r.y); x[4] = bflo(r.z); x[5] = bfhi(r.z); x[6] = bflo(r.w); x[7] = bfhi(r.w); }
__device__ __forceinline__ v4u pack8(const float (&x)[8]) { v4u w; w.x = pk2(x[0], x[1]); w.y = pk2(x[2], x[3]); w.z = pk2(x[4], x[5]); w.w = pk2(x[6], x[7]); return w; }

__device__ __forceinline__ int map_row(int kind, int n) {
    if (kind == 1) {
        if (n >= 512 && n < 1024) { const int q = n - 512; return 512 + 256 * (q >> 7) + (q & 127); }
        if (n >= 1024 && n < 1536) { const int q = n - 1024; return 512 + 256 * (q >> 7) + 128 + (q & 127); }
        return n;
    }
    if (kind == 2) { if (n < FF) return 256 * (n >> 7) + (n & 127); const int q = n - FF; return 256 * (q >> 7) + 128 + (q & 127); }
    return n;
}
__device__ __forceinline__ void transpose_item(const float* W, int K, int N, bf16* WT, int kind, LAS float* scr, int item, int lane) {
    const int nblk = N / 32, kb = item / nblk, nb = item % nblk, k0 = 64 * kb, n0 = 32 * nb;
#pragma unroll 8
    for (int i = 0; i < 32; ++i) { const int kk = 2 * i + (lane >> 5); scr[kk * 33 + (lane & 31)] = W[(size_t)(k0 + kk) * N + n0 + (lane & 31)]; }
    asm volatile("s_waitcnt lgkmcnt(0)" ::: "memory");
    const int c = lane & 7, pr0 = map_row(kind, n0);
#pragma unroll
    for (int j = 0; j < 4; ++j) { const int n = (lane >> 3) + 8 * j; const LAS float* s = scr + (8 * c) * 33 + n;
        v4u o; o.x = pk2(s[0 * 33], s[1 * 33]); o.y = pk2(s[2 * 33], s[3 * 33]); o.z = pk2(s[4 * 33], s[5 * 33]); o.w = pk2(s[6 * 33], s[7 * 33]);
        *(v4u*)(WT + (size_t)(pr0 + n) * K + k0 + 8 * c) = o; }
    asm volatile("s_waitcnt lgkmcnt(0)" ::: "memory");
}
__device__ __forceinline__ void adaln_task(int tk, const float* c, const float* c_ctx, const float* ada_w, const float* ada_b, float* mod, LAS float* T, int tid, int wave, int lane) {
    const int l = tk / 96, cb = tk % 96;
    const float* W = ada_w + (size_t)l * DM * 6144 + cb * 64 + lane;
    float acc[33];
#pragma unroll
    for (int bb = 0; bb < 33; ++bb) acc[bb] = 0.f;
    for (int half = 0; half < 2; ++half) {
        __syncthreads();
        for (int idx = tid; idx < 33 * 512; idx += NTHR) { const int bb = idx >> 9, kk = idx & 511, k = half * 512 + kk; const float cv = bb < 32 ? c[bb * DM + k] : c_ctx[k]; T[kk * 36 + bb] = cv / (1.0f + expf(-cv)); }
        __syncthreads();
        const int k0 = wave * 64;
#pragma unroll 4
        for (int kk = k0; kk < k0 + 64; ++kk) { const float wv = W[(size_t)(half * 512 + kk) * 6144];
#pragma unroll
            for (int bb = 0; bb < 33; ++bb) acc[bb] = fmaf(T[kk * 36 + bb], wv, acc[bb]); }
    }
    __syncthreads();
#pragma unroll
    for (int bb = 0; bb < 33; ++bb) T[(wave * 33 + bb) * 64 + lane] = acc[bb];
    __syncthreads();
    for (int o = tid; o < 33 * 64; o += NTHR) { const int bb = o >> 6, ln = o & 63; float s = ada_b[l * 6144 + cb * 64 + ln];
#pragma unroll
        for (int w = 0; w < 8; ++w) s += T[(w * 33 + bb) * 64 + ln];
        mod[((size_t)l * 33 + bb) * 6144 + cb * 64 + ln] = s; }
    __syncthreads();
}
__device__ __forceinline__ void rope_entry(int gt, float* rope) {
    const int pos = gt >> 5, i = gt & 31;
    const float inv = exp2f(-(float)i * 0.41524101186092029f), angf = (float)pos * inv;
    const double x = (double)angf, k = rint(x * 0.63661977236758134);
    double r = fma(-k, 1.5707963267948966, x); r = fma(-k, 6.123233995736766e-17, r);
    const double r2 = r * r;
    const double sn = r * (1.0 + r2 * (-1.0 / 6 + r2 * (1.0 / 120 + r2 * (-1.0 / 5040 + r2 * (1.0 / 362880 + r2 * (-1.0 / 39916800 + r2 * (1.0 / 6227020800.0)))))));
    const double cs = 1.0 + r2 * (-0.5 + r2 * (1.0 / 24 + r2 * (-1.0 / 720 + r2 * (1.0 / 40320 + r2 * (-1.0 / 3628800 + r2 * (1.0 / 479001600.0))))));
    const int q = ((int)k) & 3;
    const double co = q == 0 ? cs : q == 1 ? -sn : q == 2 ? -cs : sn, si = q == 0 ? sn : q == 1 ? cs : q == 2 ? -sn : -cs;
    rope[2 * gt] = (float)co; rope[2 * gt + 1] = (float)si;
}

__device__ __forceinline__ void mod_rows(const float* xl, const float* xc, const float* modl, bf16* h, int gw, int NGW, int lane) {
    for (int m = gw; m < MT; m += NGW) {
        const float* src = m < NLAT ? xl + (size_t)m * DM : xc + (size_t)(m - NLAT) * DM;
        const int bb = m < NLAT ? (m >> 11) : 32;
        const f32x4* xr = (const f32x4*)src + lane; const f32x4* sh = (const f32x4*)(modl + (size_t)bb * 6144) + lane; const f32x4* sc = (const f32x4*)(modl + (size_t)bb * 6144 + 1024) + lane;
        v2u* o = (v2u*)(h + (size_t)m * DM) + lane;
#pragma unroll
        for (int j = 0; j < 4; ++j) { const f32x4 v = xr[64 * j], a = sc[64 * j], b = sh[64 * j]; const f32x4 y = v * (a + 1.0f) + b; v2u w; w.x = pk2(y[0], y[1]); w.y = pk2(y[2], y[3]); o[64 * j] = w; }
    }
}
__device__ __forceinline__ void ln_rows(const float* src, float* dst, int rows, const float* g, const float* b, const float* modn, int sh_off, int sc_off, bf16* h, int gw, int NGW, int lane) {
    f32x4 gg[4], bv[4];
#pragma unroll
    for (int j = 0; j < 4; ++j) { gg[j] = ((const f32x4*)g)[lane + 64 * j]; bv[j] = ((const f32x4*)b)[lane + 64 * j]; }
    for (int m = gw; m < rows; m += NGW) {
        const f32x4* xr = (const f32x4*)(src + (size_t)m * DM) + lane;
        f32x4 v[4]; float s = 0.f;
#pragma unroll
        for (int j = 0; j < 4; ++j) { v[j] = xr[64 * j]; s += (v[j][0] + v[j][1]) + (v[j][2] + v[j][3]); }
        const float mean = wave_sum(s) * (1.f / DM); float s2 = 0.f;
#pragma unroll
        for (int j = 0; j < 4; ++j) { v[j] = v[j] - mean; s2 += (v[j][0] * v[j][0] + v[j][1] * v[j][1]) + (v[j][2] * v[j][2] + v[j][3] * v[j][3]); }
        const float rstd = 1.0f / sqrtf(wave_sum(s2) * (1.f / DM) + LN_EPS);
        f32x4* o = (f32x4*)(dst + (size_t)m * DM) + lane;
        const int bb = m < NLAT ? (m >> 11) : 32;
#pragma unroll
        for (int j = 0; j < 4; ++j) { const f32x4 y = v[j] * rstd * gg[j] + bv[j]; o[64 * j] = y;
            if (h) { const f32x4 a = ((const f32x4*)(modn + (size_t)bb * 6144 + sc_off))[lane + 64 * j], c = ((const f32x4*)(modn + (size_t)bb * 6144 + sh_off))[lane + 64 * j];
                const f32x4 hv = y * (a + 1.0f) + c; v2u w; w.x = pk2(hv[0], hv[1]); w.y = pk2(hv[2], hv[3]); ((v2u*)(h + (size_t)m * DM))[lane + 64 * j] = w; } }
    }
}

__device__ __forceinline__ void mixer_core(const bf16* P, bf16* Y, const float* conv_w, const float* sln_g, const float* sln_b, const bf16* Wsg, const float* sgu_b,
                                           LAS unsigned char* lds, int G, int bid, int tid) {
    const int lane = tid & 63, wave = tid >> 6, fr = lane & 15, fq = lane >> 4;
    for (long idx = (long)bid * NTHR + tid; idx < (long)MT * 64; idx += (long)G * NTHR) {
        const int row = (int)(idx >> 6), c8 = (int)(idx & 63) * 8;
        int pos, len; if (row < NLAT) { pos = row & (SEQ - 1); len = SEQ; } else { pos = (row - NLAT) & (CTXL - 1); len = CTXL; }
        const bf16* pr = P + (size_t)row * 2048;
        const v4u gb = *(const v4u*)(pr + c8), z0 = *(const v4u*)(pr + 512 + c8);
        v4u zm = (v4u){0u, 0u, 0u, 0u}, zp = (v4u){0u, 0u, 0u, 0u};
        if (pos > 0) zm = *(const v4u*)(pr - 2048 + 512 + c8);
        if (pos < len - 1) zp = *(const v4u*)(pr + 2048 + 512 + c8);
        float g_[8], a_[8], m_[8], p_[8], w0[8], w1[8], w2[8], y[8];
        unpack8(gb, g_); unpack8(z0, a_); unpack8(zm, m_); unpack8(zp, p_);
#pragma unroll
        for (int j = 0; j < 8; ++j) { w0[j] = conv_w[c8 + j]; w1[j] = conv_w[512 + c8 + j]; w2[j] = conv_w[1024 + c8 + j]; }
#pragma unroll
        for (int j = 0; j < 8; ++j) y[j] = g_[j] * (w0[j] * m_[j] + w1[j] * a_[j] + w2[j] * p_[j]);
        *(v4u*)(Y + (size_t)row * DM + c8) = pack8(y);
    }
    LAS float* stats = (LAS float*)lds;
    LAS bf16* vnt = (LAS bf16*)(lds + 1024) + wave * (32 * 136);
    for (int ch = bid; ch < MT / 128; ch += G) {
        const int row0 = ch * 128;
        __syncthreads();
        for (int r = 0; r < 16; ++r) { const int rr = wave * 16 + r;
            const v4u raw = *(const v4u*)(P + (size_t)(row0 + rr) * 2048 + 1536 + lane * 8); float x[8]; unpack8(raw, x);
            float s = 0.f;
#pragma unroll
            for (int j = 0; j < 8; ++j) s += x[j];
            const float mean = wave_sum(s) * (1.f / 512.f); float q = 0.f;
#pragma unroll
            for (int j = 0; j < 8; ++j) { const float d = x[j] - mean; q += d * d; }
            const float rstd = 1.0f / sqrtf(wave_sum(q) * (1.f / 512.f) + LN_EPS);
            if (lane == 0) { stats[2 * rr] = mean; stats[2 * rr + 1] = rstd; } }
        __syncthreads();
        const int g = wave;
        for (int dh = 0; dh < 2; ++dh) {
            const int cbase = 64 * g + 32 * dh, part = lane & 3, ql = lane >> 2;
            float lg[8], lb[8];
#pragma unroll
            for (int j = 0; j < 8; ++j) { lg[j] = sln_g[cbase + 8 * part + j]; lb[j] = sln_b[cbase + 8 * part + j]; }
#pragma unroll 2
            for (int it = 0; it < 8; ++it) { const int q = 16 * it + ql;
                const v4u raw = *(const v4u*)(P + (size_t)(row0 + q) * 2048 + 1536 + cbase + 8 * part); float x[8]; unpack8(raw, x);
                const float mean = stats[2 * q], rstd = stats[2 * q + 1];
#pragma unroll
                for (int j = 0; j < 8; j += 2) { const unsigned w = pk2((x[j] - mean) * rstd * lg[j] + lb[j], (x[j + 1] - mean) * rstd * lg[j + 1] + lb[j + 1]);
                    vnt[(8 * part + j) * 136 + q] = (bf16)(w & 0xffffu); vnt[(8 * part + j + 1) * 136 + q] = (bf16)(w >> 16); } }
            asm volatile("s_waitcnt lgkmcnt(0)" ::: "memory");
            f32x4 acc[2][8];
#pragma unroll
            for (int dt = 0; dt < 2; ++dt)
#pragma unroll
                for (int pt = 0; pt < 8; ++pt) acc[dt][pt] = (f32x4){0.f, 0.f, 0.f, 0.f};
#pragma unroll 1
            for (int ks = 0; ks < 4; ++ks) {
                bf16x8 af[2];
#pragma unroll
                for (int dt = 0; dt < 2; ++dt) af[dt] = *(const LAS bf16x8*)(vnt + (16 * dt + fr) * 136 + 32 * ks + 8 * fq);
#pragma unroll
                for (int pt = 0; pt < 8; ++pt) { const bf16x8 bw = *(const bf16x8*)(Wsg + ((size_t)g * 128 + 16 * pt + fr) * 128 + 32 * ks + 8 * fq);
#pragma unroll
                    for (int dt = 0; dt < 2; ++dt) acc[dt][pt] = __builtin_amdgcn_mfma_f32_16x16x32_bf16(af[dt], bw, acc[dt][pt], 0, 0, 0); }
            }
#pragma unroll
            for (int pt = 0; pt < 8; ++pt) { const int p = 16 * pt + fr; const float bs = sgu_b[g * 128 + p]; const size_t row = (size_t)row0 + p;
#pragma unroll
                for (int dt = 0; dt < 2; ++dt) { const int c = cbase + 16 * dt + 4 * fq; const v2u gu = *(const v2u*)(P + row * 2048 + 1024 + c);
                    v2u w; w.x = pk2(bflo(gu.x) * (acc[dt][pt][0] + bs), bfhi(gu.x) * (acc[dt][pt][1] + bs)); w.y = pk2(bflo(gu.y) * (acc[dt][pt][2] + bs), bfhi(gu.y) * (acc[dt][pt][3] + bs));
                    *(v2u*)(Y + row * DM + 512 + c) = w; } }
            asm volatile("s_waitcnt lgkmcnt(0)" ::: "memory");
        }
    }
}

__device__ __forceinline__ v4u norm_rope_chunk(v4u raw, int t, const float* gain, const float* rope, int lane) {
    const int l16 = lane & 15;
    float x[8]; unpack8(raw, x);
    float ss = 0.f;
#pragma unroll
    for (int j = 0; j < 8; ++j) ss += x[j] * x[j];
    ss += __shfl_xor(ss, 1); ss += __shfl_xor(ss, 2); ss += __shfl_xor(ss, 4); ss += __shfl_xor(ss, 8);
    const float rinv = 1.0f / sqrtf(ss * (1.f / 128.f) + RMS_EPS);
    float xn[8], pn[8], o[8];
#pragma unroll
    for (int j = 0; j < 8; ++j) xn[j] = x[j] * rinv * gain[8 * l16 + j];
#pragma unroll
    for (int j = 0; j < 8; ++j) pn[j] = __shfl_xor(xn[j], 4);
    const int a = l16 >> 3, s = (l16 >> 2) & 1, i0 = 8 * (l16 & 3);
    const int tt = t >= 0 ? t : 0, pa = a ? (tt & 63) : (tt >> 6);
    const f32x4* rp = (const f32x4*)(rope + (size_t)(pa * 32 + i0) * 2);
#pragma unroll
    for (int j2 = 0; j2 < 4; ++j2) { const f32x4 cs = rp[j2];
        const float r0 = s ? xn[2 * j2] * cs[0] + pn[2 * j2] * cs[1] : xn[2 * j2] * cs[0] - pn[2 * j2] * cs[1];
        const float r1 = s ? xn[2 * j2 + 1] * cs[2] + pn[2 * j2 + 1] * cs[3] : xn[2 * j2 + 1] * cs[2] - pn[2 * j2 + 1] * cs[3];
        o[2 * j2] = t >= 0 ? r0 : xn[2 * j2]; o[2 * j2 + 1] = t >= 0 ? r1 : xn[2 * j2 + 1]; }
    return pack8(o);
}
__device__ __forceinline__ void qk_norm_rope(bf16* Q, bf16* Kb, const float* q_g, const float* k_g, const float* rope, int gw, int NGW, int lane) {
    for (int r = gw; r < NLAT; r += NGW) {
        v4u* p = (v4u*)(Q + (size_t)r * DM) + lane; const int t = r & (SEQ - 1);
        const v4u a = p[0], b = p[64];
        p[0] = norm_rope_chunk(a, t, q_g, rope, lane); p[64] = norm_rope_chunk(b, t, q_g, rope, lane);
    }
    for (int rp = gw; rp < NB * SKV / 2; rp += NGW) {
        const int kr = 2 * rp + (lane >> 5), pos = kr % SKV; v4u* p = (v4u*)(Kb + (size_t)kr * 256) + (lane & 31);
        const v4u a = p[0];
        p[0] = norm_rope_chunk(a, pos < SEQ ? pos : -1, k_g, rope, lane);
    }
}

struct Args { const float* in[21]; float* out; unsigned char* ws; int ph_lo, ph_hi; };
__global__ void __launch_bounds__(NTHR, 2) fwd_megakernel(Args a) {
    extern __shared__ __attribute__((aligned(16))) unsigned char lds_raw[];
    cg::grid_group grid = cg::this_grid();
    LAS unsigned char* lds = (LAS unsigned char*)lds_raw;
    const int tid = threadIdx.x, lane = tid & 63, wave = __builtin_amdgcn_readfirstlane(tid >> 6);
    const int G = gridDim.x, bid = blockIdx.x, gw = bid * NWAVES + wave, NGW = G * NWAVES;
    const int lo = a.ph_lo, hi = a.ph_hi;
    unsigned char* ws = a.ws;
    const float *x_in = a.in[0], *c_in = a.in[1], *ctx_in = a.in[2], *cctx_in = a.in[3], *ada_w = a.in[4], *ada_b = a.in[5], *ln_g = a.in[6], *ln_b = a.in[7],
                *ffn_w_in = a.in[8], *ffn_w_out = a.in[9], *mix_w_in = a.in[10], *conv_w = a.in[11], *sgu_ln_g = a.in[12], *sgu_ln_b = a.in[13], *sgu_w = a.in[14], *sgu_b = a.in[15],
                *mix_w_out = a.in[16], *attn_w_qkv = a.in[17], *q_norm_g = a.in[18], *k_norm_g = a.in[19], *attn_w_out = a.in[20];
    float* mod = (float*)(ws + WS_MOD); float* rope = (float*)(ws + WS_ROPE);
    bf16 *Wsg = (bf16*)(ws + WS_WSGU), *Wmixin = (bf16*)(ws + WS_WMIXIN), *Wmixout = (bf16*)(ws + WS_WMIXOUT), *Wffnin = (bf16*)(ws + WS_WFFNIN), *Wffnout = (bf16*)(ws + WS_WFFNOUT),
         *Wqkv = (bf16*)(ws + WS_WQKV), *Waout = (bf16*)(ws + WS_WAOUT);
    float* stream = (float*)(ws + WS_STREAM);
    bf16* H = (bf16*)(ws + WS_H);
    bf16* BIG = (bf16*)(ws + WS_BIG);
    bf16 *Qb = BIG, *Kb = (bf16*)(ws + WS_BIG + BIG_K), *Vb = (bf16*)(ws + WS_BIG + BIG_V), *Ob = (bf16*)(ws + WS_BIG + BIG_O);
#ifndef PHASE_MASK
#define PHASE_MASK 0x1ffff
#endif
#define IN(k) ((((PHASE_MASK) >> (k)) & 1) && lo <= (k) && (k) < hi)
#define SEAM(k) do { if (IN(k) && IN((k) + 1)) grid.sync(); } while (0)

    if (IN(0)) {
        for (int tk = bid; tk < 192; tk += G) adaln_task(tk, c_in, cctx_in, ada_w, ada_b, mod, (LAS float*)lds, tid, wave, lane);
        __syncthreads();
        { const int gt = bid * NTHR + tid; if (gt < 64 * 32) rope_entry(gt, rope); }
        for (int i = bid * NTHR + tid; i < 8 * 128 * 128 / 2; i += G * NTHR) ((unsigned*)Wsg)[i] = pk2(sgu_w[2 * i], sgu_w[2 * i + 1]);
        LAS float* scr = (LAS float*)(lds + wave * 16384);
        constexpr int I_MI = (DM / 64) * (MIXIN / 32), I_MO = (DM / 64) * (DM / 32), I_FI = (DM / 64) * (2 * FF / 32), I_FO = (FF / 64) * (DM / 32), I_QKV = (DM / 64) * (NQKV / 32), I_AO = I_MO;
        constexpr int NITEMS = I_MI + I_MO + 2 * I_FI + 2 * I_FO + I_QKV + I_AO;
        for (int it = gw; it < NITEMS; it += NGW) {
            int r = it;
            if (r < I_MI) { transpose_item(mix_w_in, DM, MIXIN, Wmixin, 1, scr, r, lane); continue; } r -= I_MI;
            if (r < I_MO) { transpose_item(mix_w_out, DM, DM, Wmixout, 0, scr, r, lane); continue; } r -= I_MO;
            if (r < I_FI) { transpose_item(ffn_w_in, DM, 2 * FF, Wffnin, 2, scr, r, lane); continue; } r -= I_FI;
            if (r < I_FI) { transpose_item(ffn_w_in + (size_t)DM * 2 * FF, DM, 2 * FF, Wffnin + (size_t)2 * FF * DM, 2, scr, r, lane); continue; } r -= I_FI;
            if (r < I_FO) { transpose_item(ffn_w_out, FF, DM, Wffnout, 0, scr, r, lane); continue; } r -= I_FO;
            if (r < I_FO) { transpose_item(ffn_w_out + (size_t)FF * DM, FF, DM, Wffnout + (size_t)DM * FF, 0, scr, r, lane); continue; } r -= I_FO;
            if (r < I_QKV) { transpose_item(attn_w_qkv, DM, NQKV, Wqkv, 0, scr, r, lane); continue; } r -= I_QKV;
            transpose_item(attn_w_out, DM, DM, Waout, 0, scr, r, lane);
        }
        __syncthreads();
    }
    SEAM(0);
    if (IN(1)) mod_rows(x_in, ctx_in, mod, H, gw, NGW, lane);
    SEAM(1);

    if (IN(2)) { pg8::Gemm g{H, Wmixin, MT, MIXIN, DM}; pg8::StaticOrder S; S.init(MT, MIXIN, G, bid); pg8::EpiMixIn E{BIG};
        pg8::gemm_phase<pg8::EpiMixIn, pg8::StaticOrder, true, true>(lds, g, S, E); }
    SEAM(2);
    if (IN(3)) mixer_core(BIG, H, conv_w, sgu_ln_g, sgu_ln_b, Wsg, sgu_b, lds, G, bid, tid);
    SEAM(3);
#define LAYER_TAIL(L_, PB, M_, AOP, WOUT, SRC_LAT, SRC_CTX)                                                                                                         \
    if (IN(4 + PB)) { pg8::Gemm g{AOP, WOUT, M_, DM, DM}; pg8::StaticOrder S; S.init(M_, DM, G, bid);                                                               \
        pg8::EpiResid E{SRC_LAT, SRC_CTX, stream, mod + (size_t)L_ * 33 * 6144 + 2048};                                                                             \
        pg8::gemm_phase<pg8::EpiResid, pg8::StaticOrder, true, true>(lds, g, S, E); }                                                                               \
    SEAM(4 + PB);                                                                                                                                                   \
    if (IN(5 + PB)) ln_rows(stream, stream, M_, ln_g + (size_t)(2 * L_) * DM, ln_b + (size_t)(2 * L_) * DM, mod + (size_t)L_ * 33 * 6144, 3072, 4096, H, gw, NGW, lane); \
    SEAM(5 + PB);                                                                                                                                                   \
    if (IN(6 + PB)) { pg8::Gemm g{H, Wffnin + (size_t)L_ * 2 * FF * DM, M_, 2 * FF, DM}; pg8::StaticOrder S; S.init(M_, 2 * FF, G, bid); pg8::EpiSwiglu E{BIG};     \
        pg8::gemm_phase<pg8::EpiSwiglu, pg8::StaticOrder, true, true>(lds, g, S, E); }                                                                              \
    SEAM(6 + PB);                                                                                                                                                   \
    if (IN(7 + PB)) { pg8::Gemm g{BIG, Wffnout + (size_t)L_ * DM * FF, M_, DM, FF}; pg8::StaticOrder S; S.init(M_, DM, G, bid);                                     \
        pg8::EpiResid E{stream, stream + (size_t)NLAT * DM, stream, mod + (size_t)L_ * 33 * 6144 + 5120};                                                           \
        pg8::gemm_phase<pg8::EpiResid, pg8::StaticOrder, true, true>(lds, g, S, E); }                                                                               \
    SEAM(7 + PB);
    LAYER_TAIL(0, 0, MT, H, Wmixout, x_in, ctx_in)
    if (IN(8)) ln_rows(stream, stream, MT, ln_g + DM, ln_b + DM, mod + (size_t)33 * 6144, 0, 1024, H, gw, NGW, lane);
    SEAM(8);
    if (IN(9)) { pg8::Gemm g{H, Wqkv, MT, NQKV, DM}; pg8::QkvOrder S; S.init(NLAT, NQKV, G, bid); pg8::EpiQKV E{Qb, Kb, Vb};
        pg8::gemm_phase<pg8::EpiQKV, pg8::QkvOrder, true, true>(lds, g, S, E); }
    SEAM(9);
    if (IN(10)) qk_norm_rope(Qb, Kb, q_norm_g, k_norm_g, rope, gw, NGW, lane);
    SEAM(10);
    if (IN(11)) {
        for (int L = bid; L < NB * 8 * (SEQ / 256); L += G) {
            const int round = L >> 8, c = L & 255, xq = c & 7, s = c >> 3;
            const int b = 4 * round + (xq >> 1), kvh = xq & 1, h = 4 * kvh + (s >> 3), qb = s & 7;
            const size_t qoff = ((size_t)b * SEQ + 256 * qb) * DM + 128 * h, koff = (size_t)b * SKV * 256 + 128 * kvh;
            att::attn_dense_body<att::bf16>(Qb + qoff, Kb + koff, Vb + koff, Ob + qoff, SKV, (char*)lds_raw);
            __syncthreads();
        }
    }
    SEAM(11);
    LAYER_TAIL(1, 8, NLAT, Ob, Waout, stream, stream + (size_t)NLAT * DM)
    if (IN(16)) ln_rows(stream, a.out, NLAT, ln_g + 3 * DM, ln_b + 3 * DM, nullptr, 0, 0, nullptr, gw, NGW, lane);
#undef LAYER_TAIL
#undef IN
#undef SEAM
}

#ifndef MK_PER_PHASE
#define MK_PER_PHASE 1
#endif
extern "C" void kernel_launch(void* const* d_in, const int* in_sizes, int n_in, void* d_out, int out_size, void* d_ws, size_t ws_size, hipStream_t stream) {
    static int grid = 0;
    if (grid == 0) {
        if (n_in != 21 || in_sizes[0] != NLAT * DM || out_size != NLAT * DM || ws_size < WS_END) {
            fprintf(stderr, "kernel_launch: unexpected shapes: n_in %d in0 %d out %d ws %zu (need %zu)\n", n_in, n_in > 0 ? in_sizes[0] : -1, out_size, ws_size, (size_t)WS_END); grid = -1; return; }
        int dev = 0, cus = 0, per_cu = 0;
        if (hipGetDevice(&dev) != hipSuccess || hipDeviceGetAttribute(&cus, hipDeviceAttributeMultiprocessorCount, dev) != hipSuccess) { fprintf(stderr, "kernel_launch: device query failed\n"); grid = -1; return; }
        if (hipFuncSetAttribute((const void*)fwd_megakernel, hipFuncAttributeMaxDynamicSharedMemorySize, LDS_BYTES) != hipSuccess) { fprintf(stderr, "kernel_launch: hipFuncSetAttribute failed\n"); grid = -1; return; }
        if (hipOccupancyMaxActiveBlocksPerMultiprocessor(&per_cu, (const void*)fwd_megakernel, NTHR, LDS_BYTES) != hipSuccess || per_cu < 1) { fprintf(stderr, "kernel_launch: occupancy query says %d blocks per CU\n", per_cu); per_cu = 1; }
        (void)hipGetLastError();
        grid = cus * per_cu;
        fprintf(stderr, "kernel_launch: %d CUs x %d = grid %d\n", cus, per_cu, grid);
    }
    if (grid < 0) return;
    Args a{};
    for (int i = 0; i < 21; ++i) a.in[i] = (const float*)d_in[i];
    a.out = (float*)d_out; a.ws = (unsigned char*)d_ws;
#if MK_PER_PHASE
    for (int ph = 0; ph < NPH; ++ph) { a.ph_lo = ph; a.ph_hi = ph + 1; hipLaunchKernelGGL(fwd_megakernel, dim3(grid), dim3(NTHR), LDS_BYTES, stream, a); }
#else
    a.ph_lo = 0; a.ph_hi = NPH;
    void* args[] = {&a};
    const hipError_t e = hipLaunchCooperativeKernel((const void*)fwd_megakernel, dim3(grid), dim3(NTHR), args, LDS_BYTES, stream);
    if (e != hipSuccess) fprintf(stderr, "kernel_launch: cooperative launch failed: %s (grid %d)\n", hipGetErrorString(e), grid);
#endif
}
```

```cpp
#include <hip/hip_runtime.h>
#include <hip/hip_cooperative_groups.h>
#include <cstdio>
#include <cstdint>
namespace cg = cooperative_groups;

namespace pg8 {
#define PG8_LAS __attribute__((address_space(3)))
typedef unsigned short bf16_t;
typedef short bf16x8 __attribute__((ext_vector_type(8)));
typedef float f32x4 __attribute__((ext_vector_type(4)));
typedef unsigned u32x4 __attribute__((ext_vector_type(4)));
constexpr int BM = 256, BK = 64, HALF = 128, HTB = HALF * BK * 2  , STAGE_BYTES = 8 * HTB, NXCD = 8, WGM = 8;

__host__ __device__ __forceinline__ int lds_byte(int r, int c) { const int st = (r >> 4) * 2 + (c >> 5), rr = r & 15, cc = c & 31, ob = rr * 64 + cc * 2; return st * 1024 + (ob ^ (((ob >> 9) & 1) << 5)); }
__host__ __device__ __forceinline__ void stage_rc(int b, int& R, int& C) { const int st = b / 1024, sb = b % 1024, swz = sb ^ (((sb >> 9) & 1) << 5); R = (st >> 1) * 16 + swz / 64; C = (st & 1) * 32 + (swz % 64) / 2; }
__host__ __device__ __forceinline__ int perm32(int rho) { const int n = rho >> 4, i = rho & 15; return 8 * (i >> 2) + 4 * n + (i & 3); }

struct Unit { int pm, pn; };
struct Gemm { const bf16_t* A; const bf16_t* Bt; int M, N, K; };

struct StaticOrder {
    int nM, nN, nwg, G, c;
    __host__ __device__ void init(int M, int N, int G_, int c_) { nM = M / BM; nN = N / BM; nwg = nM * nN; G = G_; c = c_; }
    __host__ __device__ bool next(int i, Unit& u) const {
        const long L = (long)i * G + c; if (L >= nwg) return false;
        int wgid = (int)L; { const int q = nwg / NXCD, r = nwg % NXCD, xcd = wgid % NXCD, off = wgid / NXCD; wgid = (xcd < r ? xcd * (q + 1) : r * (q + 1) + (xcd - r) * q) + off; }
        const int nig = WGM * nN, gid = wgid / nig, fm = gid * WGM, gsz = (nM - fm) < WGM ? (nM - fm) : WGM;
        u.pm = fm + ((wgid % nig) % gsz); u.pn = (wgid % nig) / gsz; return true;
    }
    __device__ __forceinline__ void a_ready(const Unit&) const {}
    __device__ __forceinline__ void done(const Unit&) const {}
};

__device__ __forceinline__ unsigned cvt_pk_bf16(float lo, float hi) { unsigned r; asm volatile("v_cvt_pk_bf16_f32 %0, %1, %2" : "=v"(r) : "v"(lo), "v"(hi)); return r; }
typedef float f32x2 __attribute__((ext_vector_type(2)));
__device__ __forceinline__ f32x2 gelu_pk(f32x2 v) {
    const f32x2 av = __builtin_elementwise_abs(v), d = av * 0.2316418882f + 1.0f;
    f32x2 t; t.x = __builtin_amdgcn_rcpf(d.x); t.y = __builtin_amdgcn_rcpf(d.y);
    f32x2 q = t * 0.5307027145f + (-0.7265760135f); q = q * t + 0.7107068705f; q = q * t + (-0.142248368f); q = q * t + 0.127414796f; q = q * t;
    const f32x2 s = (v * v) * (-0.72134752044f);
    f32x2 e; e.x = __builtin_amdgcn_exp2f(s.x); e.y = __builtin_amdgcn_exp2f(s.y);
    const f32x2 m = v * (q * e), r = v - m;
    f32x2 o; o.x = v.x < 0.f ? m.x : r.x; o.y = v.y < 0.f ? m.y : r.y; return o;
}

constexpr int DM = 1024;
constexpr float ALPHA_RES = 1.4142135623730951f;
__device__ __forceinline__ void st_bf8(bf16_t* p, f32x4 v0, f32x4 v1) {
    u32x4 w; w.x = cvt_pk_bf16(v0[0], v0[1]); w.y = cvt_pk_bf16(v0[2], v0[3]); w.z = cvt_pk_bf16(v1[0], v1[1]); w.w = cvt_pk_bf16(v1[2], v1[3]);
    *(u32x4*)p = w;
}
__device__ __forceinline__ f32x4 gelu4(f32x4 v) { f32x2 a = gelu_pk((f32x2){v[0], v[1]}), b = gelu_pk((f32x2){v[2], v[3]}); return (f32x4){a.x, a.y, b.x, b.y}; }
__device__ __forceinline__ float silu1(float g) { return g * __builtin_amdgcn_rcpf(1.0f + __builtin_amdgcn_exp2f(-1.4426950408889634f * g)); }
__device__ __forceinline__ f32x4 swiglu4(f32x4 g, f32x4 u) { return (f32x4){silu1(g[0]) * u[0], silu1(g[1]) * u[1], silu1(g[2]) * u[2], silu1(g[3]) * u[3]}; }

struct EpiMixIn {
    static constexpr bool PERM = true, AFTER_DRAIN = false;
    bf16_t* P;
    __device__ __forceinline__ void operator()(const f32x4 (&acc)[2][2][4][2], const Unit& u, int wr, int wc, int fr, int fq) const {
        const int row0 = u.pm * BM + wr * 64 + fr, cw = wc * 32 + 8 * fq;
        if (u.pn < 2) {
#pragma unroll
            for (int ai = 0; ai < 2; ++ai)
#pragma unroll
                for (int m = 0; m < 4; ++m) { bf16_t* rowp = P + (size_t)(row0 + ai * HALF + m * 16) * 2048 + u.pn * 256 + cw;
#pragma unroll
                    for (int bj = 0; bj < 2; ++bj) st_bf8(rowp + bj * HALF, acc[ai][bj][m][0], acc[ai][bj][m][1]); }
        } else if (u.pn < 6) {
#pragma unroll
            for (int ai = 0; ai < 2; ++ai)
#pragma unroll
                for (int m = 0; m < 4; ++m) { bf16_t* rowp = P + (size_t)(row0 + ai * HALF + m * 16) * 2048 + 512 + (u.pn - 2) * 128 + cw;
                    st_bf8(rowp, acc[ai][0][m][0] * acc[ai][1][m][0], acc[ai][0][m][1] * acc[ai][1][m][1]); }
        } else {
#pragma unroll
            for (int ai = 0; ai < 2; ++ai)
#pragma unroll
                for (int m = 0; m < 4; ++m) { bf16_t* rowp = P + (size_t)(row0 + ai * HALF + m * 16) * 2048 + 1024 + (u.pn - 6) * 256 + cw;
#pragma unroll
                    for (int bj = 0; bj < 2; ++bj) st_bf8(rowp + bj * HALF, gelu4(acc[ai][bj][m][0]), gelu4(acc[ai][bj][m][1])); }
        }
    }
};
struct EpiSwiglu {
    static constexpr bool PERM = true, AFTER_DRAIN = false;
    bf16_t* H;
    __device__ __forceinline__ void operator()(const f32x4 (&acc)[2][2][4][2], const Unit& u, int wr, int wc, int fr, int fq) const {
        const int row0 = u.pm * BM + wr * 64 + fr, cw = wc * 32 + 8 * fq;
#pragma unroll
        for (int ai = 0; ai < 2; ++ai)
#pragma unroll
            for (int m = 0; m < 4; ++m) { bf16_t* rowp = H + (size_t)(row0 + ai * HALF + m * 16) * 2816 + u.pn * 128 + cw;
                st_bf8(rowp, swiglu4(acc[ai][0][m][0], acc[ai][1][m][0]), swiglu4(acc[ai][0][m][1], acc[ai][1][m][1])); }
    }
};
struct EpiResid {
    static constexpr bool PERM = false, AFTER_DRAIN = false;
    const float* src_lat; const float* src_ctx; float* dst; const float* gate;
    __device__ __forceinline__ void operator()(const f32x4 (&acc)[2][2][4][2], const Unit& u, int wr, int wc, int fr, int fq) const {
        const int bb = u.pm < 256 ? (u.pm >> 3) : 32;
        const int col0 = u.pn * BM + wc * 32 + 4 * fq, r_in = wr * 64 + fr;
        const float* gp = gate + (size_t)bb * 6144 + col0;
        const float* sbase = (u.pm < 256 ? src_lat + (size_t)u.pm * BM * DM : src_ctx + (size_t)(u.pm - 256) * BM * DM) + (size_t)r_in * DM + col0;
        float* dbase = dst + (size_t)u.pm * BM * DM + (size_t)r_in * DM + col0;
#pragma unroll
        for (int bj = 0; bj < 2; ++bj)
#pragma unroll
            for (int n = 0; n < 2; ++n) { const f32x4 gv = *(const f32x4*)(gp + bj * HALF + n * 16);
#pragma unroll
                for (int ai = 0; ai < 2; ++ai) {
#pragma unroll
                    for (int m = 0; m < 4; ++m) { const int off = (ai * HALF + m * 16) * DM + bj * HALF + n * 16; const f32x4 sv = *(const f32x4*)(sbase + off);
                        *(f32x4*)(dbase + off) = sv * ALPHA_RES + gv * acc[ai][bj][m][n]; }
                    asm volatile("" ::: "memory"); } }
    }
};
struct QkvOrder : StaticOrder {
    __device__ bool next(int i, Unit& u) const {
        const long L = (long)i * G + c;
        if (L < nwg) return StaticOrder::next(i, u);
        const int j = (int)(L - nwg); if (j >= 64) return false;
        u.pm = 256 + (j & 31); u.pn = 4 + (j >> 5); return true;
    }
};
struct EpiQKV {
    static constexpr bool PERM = true, AFTER_DRAIN = false;
    bf16_t* Q; bf16_t* Kb; bf16_t* Vb;
    __device__ __forceinline__ void operator()(const f32x4 (&acc)[2][2][4][2], const Unit& u, int wr, int wc, int fr, int fq) const {
        const int cw = wc * 32 + 8 * fq, r_in = wr * 64 + fr;
        constexpr int pn_k = 4; const bool is_ctx = u.pm >= 256;
        if (u.pn < pn_k) {
#pragma unroll
            for (int ai = 0; ai < 2; ++ai)
#pragma unroll
                for (int m = 0; m < 4; ++m) { bf16_t* rowp = Q + (size_t)(u.pm * BM + r_in + ai * HALF + m * 16) * 1024 + u.pn * 256 + cw;
#pragma unroll
                    for (int bj = 0; bj < 2; ++bj) st_bf8(rowp + bj * HALF, acc[ai][bj][m][0], acc[ai][bj][m][1]); }
        } else {
            bf16_t* base = (u.pn == pn_k) ? Kb : Vb;
            const size_t kvrow0 = is_ctx ? (size_t)(u.pm - 256) * 2304 + 2048 : (size_t)(u.pm >> 3) * 2304 + (size_t)(u.pm & 7) * 256;
#pragma unroll
            for (int ai = 0; ai < 2; ++ai)
#pragma unroll
                for (int m = 0; m < 4; ++m) { bf16_t* rowp = base + (kvrow0 + r_in + ai * HALF + m * 16) * 256 + cw;
#pragma unroll
                    for (int bj = 0; bj < 2; ++bj) st_bf8(rowp + bj * HALF, acc[ai][bj][m][0], acc[ai][bj][m][1]); }
        }
    }
};

template <class Epi, class Sched, bool ALIGN_EPI = false, bool SP2 = false>
__device__ __forceinline__ void gemm_phase(PG8_LAS unsigned char* lds, const Gemm g, const Sched& S, const Epi& E) {
    int tid_ = threadIdx.x; asm volatile("" : "+v"(tid_));
    const int tid = tid_, wid = __builtin_amdgcn_readfirstlane(tid >> 6), lane = tid & 63, wr = wid >> 2, wc = wid & 3, fr = lane & 15, fq = lane >> 4;
    const int K = g.K, nt = K / BK;
    unsigned voffA[2], voffB[2];
#pragma unroll
    for (int i = 0; i < 2; ++i) { int R, C; stage_rc(tid * 16 + i * 8192, R, C); const int Rb = Epi::PERM ? ((R & ~31) + perm32(R & 31)) : R;
        voffA[i] = (unsigned)(R * K + C) * 2u; voffB[i] = (unsigned)(Rb * K + C) * 2u; }
    const size_t kstep = (size_t)(BK * 2);
    const size_t hstep = (size_t)HALF * K * 2;
    const size_t tstep = 2 * hstep;
    const unsigned ldsw = (unsigned)wid * 1024u;
    const int aoff = lds_byte(wr * 64 + fr, fq * 8), boff = lds_byte(wc * 32 + fr, fq * 8);
#define PG8_SA(b, h) (((b) * 2 + (h)) * HTB)
#define PG8_SB(b, h) ((4 + (b) * 2 + (h)) * HTB)
#define PG8_STAGE(bufoff, gbase, voff) do { _Pragma("unroll") for (int _i = 0; _i < 2; ++_i) \
        __builtin_amdgcn_global_load_lds((const unsigned*)((const char*)(gbase) + (voff)[_i]), (PG8_LAS unsigned*)(lds + (bufoff) + ldsw + _i * 8192), 16, 0, 0); } while (0)
#define PG8_LDA(dst, b, h) do { _Pragma("unroll") for (int m = 0; m < 4; ++m) _Pragma("unroll") for (int k = 0; k < 2; ++k) dst[m][k] = *(const PG8_LAS bf16x8*)(lds + PG8_SA(b, h) + aoff + m * 2048 + k * 1024); } while (0)
#define PG8_LDB(dst, b, h) do { _Pragma("unroll") for (int n = 0; n < 2; ++n) _Pragma("unroll") for (int k = 0; k < 2; ++k) dst[n][k] = *(const PG8_LAS bf16x8*)(lds + PG8_SB(b, h) + boff + n * 2048 + k * 1024); } while (0)
#define PG8_MMA(ai, bj, At, Bt) do { __builtin_amdgcn_s_setprio(1); _Pragma("unroll") for (int m = 0; m < 4; ++m) _Pragma("unroll") for (int n = 0; n < 2; ++n) _Pragma("unroll") for (int k = 0; k < 2; ++k) \
        acc[ai][bj][m][n] = __builtin_amdgcn_mfma_f32_16x16x32_bf16(Bt[n][k], At[m][k], acc[ai][bj][m][n], 0, 0, 0); __builtin_amdgcn_s_setprio(0); } while (0)
#define PG8_WAIT_V(n) asm volatile("s_waitcnt vmcnt(" #n ")" ::: "memory")
#define PG8_WAIT_L(n) asm volatile("s_waitcnt lgkmcnt(" #n ")" ::: "memory")
#define PG8_BAR __builtin_amdgcn_s_barrier()
#define PG8_SCHED __builtin_amdgcn_sched_barrier(0)
    Unit cur, nxt; int ui = 0;
    if (!S.next(0, cur)) return;
    f32x4 acc[2][2][4][2];
#pragma unroll
    for (int a = 0; a < 2; ++a)
#pragma unroll
        for (int b = 0; b < 2; ++b)
#pragma unroll
            for (int m = 0; m < 4; ++m)
#pragma unroll
                for (int n = 0; n < 2; ++n) acc[a][b][m][n] = (f32x4){0.f, 0.f, 0.f, 0.f};
    bf16x8 At[4][2], B0[2][2], B1[2][2];
    const char* cA = (const char*)g.A + (size_t)cur.pm * tstep; const char* cB = (const char*)g.Bt + (size_t)cur.pn * tstep;
    S.a_ready(cur);
    if constexpr (SP2) {
        PG8_STAGE(PG8_SB(0, 0), cB, voffB); PG8_STAGE(PG8_SB(0, 1), cB + hstep, voffB); PG8_STAGE(PG8_SA(0, 0), cA, voffA); PG8_STAGE(PG8_SA(0, 1), cA + hstep, voffA);
        if (wr == 1) PG8_BAR;
        PG8_WAIT_V(2); PG8_BAR;
        PG8_STAGE(PG8_SB(1, 0), cB + kstep, voffB); PG8_STAGE(PG8_SA(1, 0), cA + kstep, voffA); PG8_STAGE(PG8_SB(1, 1), cB + hstep + kstep, voffB);
        PG8_WAIT_V(6); PG8_BAR;
    } else {
        PG8_STAGE(PG8_SB(0, 0), cB, voffB); PG8_STAGE(PG8_SA(0, 0), cA, voffA); PG8_STAGE(PG8_SB(0, 1), cB + hstep, voffB); PG8_STAGE(PG8_SA(0, 1), cA + hstep, voffA);
        if (wr == 1) PG8_BAR;
        PG8_WAIT_V(4); PG8_BAR;
        PG8_STAGE(PG8_SB(1, 0), cB + kstep, voffB); PG8_STAGE(PG8_SA(1, 0), cA + kstep, voffA); PG8_STAGE(PG8_SB(1, 1), cB + hstep + kstep, voffB);
        PG8_WAIT_V(6); PG8_BAR;
    }
    for (;;) {
        const bool has_next = S.next(ui + 1, nxt);
        const char* nA = has_next ? (const char*)g.A + (size_t)nxt.pm * tstep : cA; const char* nB = has_next ? (const char*)g.Bt + (size_t)nxt.pn * tstep : cB;
        for (int t = 0; t < nt; t += 2) {
            const bool last = (t == nt - 2);
            const char* a1 = cA + (size_t)(t + 1) * kstep;
            const char* a2 = last ? nA : cA + (size_t)(t + 2) * kstep; const char* b2 = last ? nB : cB + (size_t)(t + 2) * kstep;
            const char* a3 = a2 + kstep; const char* b3 = b2 + kstep;
            if (last && has_next) S.a_ready(nxt);
            if constexpr (SP2) {
            PG8_LDB(B0, 0, 0); PG8_LDB(B1, 0, 1); PG8_SCHED; PG8_LDA(At, 0, 0); PG8_STAGE(PG8_SA(1, 1), a1 + hstep, voffA);
            PG8_WAIT_V(8); PG8_WAIT_L(0); PG8_BAR; PG8_MMA(0, 0, At, B0); PG8_MMA(0, 1, At, B1); PG8_BAR; PG8_SCHED;
            PG8_LDA(At, 0, 1); PG8_STAGE(PG8_SB(0, 0), b2, voffB); PG8_STAGE(PG8_SB(0, 1), b2 + hstep, voffB); PG8_STAGE(PG8_SA(0, 0), a2, voffA);
            PG8_WAIT_V(8); PG8_WAIT_L(0); PG8_BAR; PG8_MMA(1, 0, At, B0); PG8_MMA(1, 1, At, B1); PG8_BAR; PG8_SCHED;
            PG8_LDB(B0, 1, 0); PG8_LDB(B1, 1, 1); PG8_SCHED; PG8_LDA(At, 1, 0); PG8_STAGE(PG8_SA(0, 1), a2 + hstep, voffA);
            PG8_WAIT_V(8); PG8_WAIT_L(0); PG8_BAR; PG8_MMA(0, 0, At, B0); PG8_MMA(0, 1, At, B1); PG8_BAR; PG8_SCHED;
            PG8_LDA(At, 1, 1); PG8_STAGE(PG8_SB(1, 0), b3, voffB); PG8_STAGE(PG8_SB(1, 1), b3 + hstep, voffB); PG8_STAGE(PG8_SA(1, 0), a3, voffA);
            PG8_WAIT_V(8); PG8_WAIT_L(0); PG8_BAR; PG8_MMA(1, 0, At, B0); PG8_MMA(1, 1, At, B1); PG8_BAR; PG8_SCHED;
            } else {
            PG8_LDB(B0, 0, 0); PG8_SCHED; PG8_LDA(At, 0, 0); PG8_STAGE(PG8_SA(1, 1), a1 + hstep, voffA);
            PG8_WAIT_L(8); PG8_BAR; PG8_WAIT_L(0); PG8_MMA(0, 0, At, B0); PG8_BAR; PG8_SCHED;
            PG8_LDB(B1, 0, 1); PG8_STAGE(PG8_SB(0, 0), b2, voffB);
            PG8_BAR; PG8_WAIT_L(0); PG8_MMA(0, 1, At, B1); PG8_BAR;
            PG8_LDA(At, 0, 1); PG8_STAGE(PG8_SA(0, 0), a2, voffA);
            PG8_BAR; PG8_WAIT_L(0); PG8_MMA(1, 0, At, B0); PG8_BAR; PG8_SCHED;
            PG8_STAGE(PG8_SB(0, 1), b2 + hstep, voffB);
            PG8_WAIT_V(6); PG8_BAR; PG8_MMA(1, 1, At, B1); PG8_BAR;
            PG8_LDB(B0, 1, 0); PG8_SCHED; PG8_LDA(At, 1, 0); PG8_STAGE(PG8_SA(0, 1), a2 + hstep, voffA);
            PG8_WAIT_L(8); PG8_BAR; PG8_WAIT_L(0); PG8_MMA(0, 0, At, B0); PG8_BAR; PG8_SCHED;
            PG8_LDB(B1, 1, 1); PG8_STAGE(PG8_SB(1, 0), b3, voffB);
            PG8_BAR; PG8_WAIT_L(0); PG8_MMA(0, 1, At, B1); PG8_BAR;
            PG8_LDA(At, 1, 1); PG8_STAGE(PG8_SA(1, 0), a3, voffA);
            PG8_BAR; PG8_WAIT_L(0); PG8_MMA(1, 0, At, B0); PG8_BAR; PG8_SCHED;
            PG8_STAGE(PG8_SB(1, 1), b3 + hstep, voffB);
            PG8_WAIT_V(6); PG8_BAR; PG8_MMA(1, 1, At, B1); PG8_BAR;
            }
        }
        if constexpr (ALIGN_EPI) { if (wr == 0) PG8_BAR; }
        if constexpr (!Epi::AFTER_DRAIN) { E(acc, cur, wr, wc, fr, fq); S.done(cur); }
        if (!has_next) break;
#pragma unroll
        for (int a = 0; a < 2; ++a)
#pragma unroll
            for (int b = 0; b < 2; ++b)
#pragma unroll
                for (int m = 0; m < 4; ++m)
#pragma unroll
                    for (int n = 0; n < 2; ++n) acc[a][b][m][n] = (f32x4){0.f, 0.f, 0.f, 0.f};
        cur = nxt; cA = nA; cB = nB; ++ui;
        if constexpr (ALIGN_EPI) { if (wr == 1) PG8_BAR; }
    }
    PG8_WAIT_V(0);
    if constexpr (!ALIGN_EPI) { if (wr == 0) PG8_BAR; }
    PG8_BAR;
    if constexpr (Epi::AFTER_DRAIN) { E.fused(acc, cur, wr, wc, fr, fq, lds, wid, lane); S.done(cur); }
#undef PG8_SA
#undef PG8_SB
#undef PG8_STAGE
#undef PG8_LDA
#undef PG8_LDB
#undef PG8_MMA
#undef PG8_WAIT_V
#undef PG8_WAIT_L
#undef PG8_BAR
#undef PG8_SCHED
}
}

namespace att {
typedef unsigned short bf16;
constexpr int   D = 128, NW = 8, QBLK = 32, KVBLK = 64;
constexpr float SCALE = 0.088388347648318440f;
constexpr float THR = 8.f;
constexpr int SDEPTH = 2;
constexpr int LDQ = 1024, LDK = 256, LDO = 1024;
constexpr size_t SHM_V = KVBLK * D * 2, SHM_K = KVBLK * D * 2, SHM_ATTN = 2 * SHM_V + 2 * SHM_K + NW * 64 * 4;
using bf16x8 = __attribute__((ext_vector_type(8))) short;
using s16x4  = __attribute__((ext_vector_type(4))) short;
using f32x16 = __attribute__((ext_vector_type(16))) float;
using f32x8  = __attribute__((ext_vector_type(8))) float;
using u32x4  = __attribute__((ext_vector_type(4))) unsigned;
#define KSWZ(row, colB) ((row) * 256 + ((colB) ^ (((row) & 7) << 4)))
#define SBAR() __builtin_amdgcn_sched_barrier(0)
__device__ __forceinline__ int crow(int r, int hi) { return (r & 3) + 8 * (r >> 2) + 4 * hi; }
__device__ __forceinline__ unsigned cvtpk(float lo, float hi) {
  unsigned r; asm volatile("v_cvt_pk_bf16_f32 %0, %1, %2" : "=v"(r) : "v"(lo), "v"(hi)); return r;
}
template <typename TIn> struct Stage;
template <> struct Stage<bf16>  { using T = bf16x8;
  __device__ static __forceinline__ T ld8(const bf16* p) { return *reinterpret_cast<const bf16x8*>(p); }
  __device__ static __forceinline__ bf16x8 tobf(T x) { return x; } };
template <> struct Stage<float> { using T = f32x8;
  __device__ static __forceinline__ T ld8(const float* p) { return *reinterpret_cast<const f32x8*>(p); }
  __device__ static __forceinline__ bf16x8 tobf(T x) {
    u32x4 w = {cvtpk(x[0], x[1]), cvtpk(x[2], x[3]), cvtpk(x[4], x[5]), cvtpk(x[6], x[7])}; return *reinterpret_cast<bf16x8*>(&w); } };

__device__ __forceinline__ void partialSM(f32x16& p0, f32x16& p1, float& m_reg, float& mn, float& alpha) {
  constexpr float C = SCALE * 1.4426950408889634f;
  float pmax = p0[0]; for (int r = 1; r < 16; ++r) pmax = fmaxf(pmax, p0[r]); for (int r = 0; r < 16; ++r) pmax = fmaxf(pmax, p1[r]);
  { auto rr = __builtin_amdgcn_permlane32_swap(__float_as_uint(pmax), __float_as_uint(pmax), false, false);
    pmax = fmaxf(__uint_as_float(rr[0]), __uint_as_float(rr[1])); }
  if (__builtin_expect(__all(pmax - m_reg <= THR / SCALE), 1)) { mn = m_reg; alpha = 1.f; }
  else { mn = fmaxf(m_reg, pmax); alpha = __builtin_amdgcn_exp2f((m_reg - mn) * C); m_reg = mn; }
  float mnC = -mn * C;
  for (int r = 0; r < 16; ++r) p0[r] = fmaf(p0[r], C, mnC); for (int r = 0; r < 16; ++r) p1[r] = fmaf(p1[r], C, mnC);
  for (int r = 0; r < 16; ++r) p0[r] = __builtin_amdgcn_exp2f(p0[r]);
}
__device__ __forceinline__ void finishSM(f32x16& p0, f32x16& p1, float alpha, float& l_reg, bf16x8& pa0, bf16x8& pa1, bf16x8& pa2, bf16x8& pa3) {
  for (int r = 0; r < 16; ++r) p1[r] = __builtin_amdgcn_exp2f(p1[r]);
  float ps = 0; for (int r = 0; r < 16; ++r) ps += p0[r]; for (int r = 0; r < 16; ++r) ps += p1[r];
  { auto rr = __builtin_amdgcn_permlane32_swap(__float_as_uint(ps), __float_as_uint(ps), false, false);
    ps = __uint_as_float(rr[0]) + __uint_as_float(rr[1]); }
  l_reg = l_reg * alpha + ps;
#define PK4(P, BASE, OUT) do { unsigned a0 = cvtpk(P[BASE + 0], P[BASE + 1]), a1 = cvtpk(P[BASE + 2], P[BASE + 3]);   \
    unsigned b0 = cvtpk(P[BASE + 4], P[BASE + 5]), b1 = cvtpk(P[BASE + 6], P[BASE + 7]);                              \
    auto r0 = __builtin_amdgcn_permlane32_swap(a0, b0, false, false); auto r1 = __builtin_amdgcn_permlane32_swap(a1, b1, false, false); \
    u32x4 w = {r0[0], r1[0], r0[1], r1[1]}; OUT = *reinterpret_cast<bf16x8*>(&w); } while (0)
  PK4(p0, 0, pa0); PK4(p0, 8, pa1); PK4(p1, 0, pa2); PK4(p1, 8, pa3);
#undef PK4
}
__device__ __forceinline__ void qkt(f32x16& p0, f32x16& p1, const bf16* Ks, const bf16x8* qr, int r32, int hi) {
  p0 = f32x16{}; p1 = f32x16{};
  for (int d0 = 0; d0 < 8; ++d0) { int cb = (d0 * 16 + hi * 8) * 2;
    bf16x8 b0 = *reinterpret_cast<const bf16x8*>((const char*)Ks + KSWZ(r32, cb));
    bf16x8 b1 = *reinterpret_cast<const bf16x8*>((const char*)Ks + KSWZ(32 + r32, cb));
    p0 = __builtin_amdgcn_mfma_f32_32x32x16_bf16(b0, qr[d0], p0, 0, 0, 0);
    p1 = __builtin_amdgcn_mfma_f32_32x32x16_bf16(b1, qr[d0], p1, 0, 0, 0); }
}
__device__ __forceinline__ int v_st(int k, int c) { const int kk = (k & ~0xC) | ((k & 4) << 1) | ((k & 8) >> 1); return ((kk >> 3) * 4 + (c >> 5)) * 512 + ((kk & 7) * 32 + (c & 31)) * 2; }
__device__ __forceinline__ int v_rd_base(int lane) { return ((lane & 3) << 3) | (((lane >> 2) & 3) << 6) | (((lane >> 4) & 1) << 5) | (((lane >> 5) & 1) << 8); }
constexpr int v_rd_off(int d0, int ks, int half) { return d0 * 512 + ks * 4096 + half * 2048; }
template <int OFF> __device__ __forceinline__ s16x4 tr_read(int vb) {
  s16x4 r; asm volatile("ds_read_b64_tr_b16 %0, %1 offset:%2" : "=&v"(r) : "v"(vb), "i"(OFF) : "memory"); return r;
}
template <int D0> __device__ __forceinline__ void pv_one(f32x16& od, int vb, bf16x8 pa0, bf16x8 pa1, bf16x8 pa2, bf16x8 pa3) {
  const s16x4 l0 = tr_read<v_rd_off(D0, 0, 0)>(vb), h0 = tr_read<v_rd_off(D0, 0, 1)>(vb), l1 = tr_read<v_rd_off(D0, 1, 0)>(vb), h1 = tr_read<v_rd_off(D0, 1, 1)>(vb);
  const s16x4 l2 = tr_read<v_rd_off(D0, 2, 0)>(vb), h2 = tr_read<v_rd_off(D0, 2, 1)>(vb), l3 = tr_read<v_rd_off(D0, 3, 0)>(vb), h3 = tr_read<v_rd_off(D0, 3, 1)>(vb);
  asm volatile("s_waitcnt lgkmcnt(0)" ::: "memory"); SBAR();
#define PK(L, H) (bf16x8){L[0], L[1], L[2], L[3], H[0], H[1], H[2], H[3]}
  od = __builtin_amdgcn_mfma_f32_32x32x16_bf16(pa0, PK(l0, h0), od, 0, 0, 0);
  od = __builtin_amdgcn_mfma_f32_32x32x16_bf16(pa1, PK(l1, h1), od, 0, 0, 0);
  od = __builtin_amdgcn_mfma_f32_32x32x16_bf16(pa2, PK(l2, h2), od, 0, 0, 0);
  od = __builtin_amdgcn_mfma_f32_32x32x16_bf16(pa3, PK(l3, h3), od, 0, 0, 0);
#undef PK
}
__device__ __forceinline__ void pv_d0(f32x16* o, int vb, bf16x8 pa0, bf16x8 pa1, bf16x8 pa2, bf16x8 pa3) {
  pv_one<0>(o[0], vb, pa0, pa1, pa2, pa3); pv_one<1>(o[1], vb, pa0, pa1, pa2, pa3); pv_one<2>(o[2], vb, pa0, pa1, pa2, pa3); pv_one<3>(o[3], vb, pa0, pa1, pa2, pa3);
}

template <typename TQ>
__device__ __forceinline__ void attn_dense_body(const TQ* __restrict__ Qb, const bf16* __restrict__ Kh, const bf16* __restrict__ Vh,
                                                bf16* __restrict__ Ob, int seq, char* lds) {
  using St = Stage<bf16>; using SQ = Stage<TQ>;
  int tid_ = threadIdx.x; asm volatile("" : "+v"(tid_));
  const int tid = tid_, wid = tid >> 6, lane = tid & 63, r32 = lane & 31, hi = lane >> 5;
  bf16* V_lds = (bf16*)lds; bf16* K_lds = (bf16*)(lds + 2 * SHM_V);
  float* ws = (float*)(lds + 2 * SHM_V + 2 * SHM_K) + wid * 64; float* li_l = ws; float* al_l = ws + 32;
  float m_reg = -1e30f, l_reg = 0; f32x16 o[4] = {}; bf16x8 qr[8];
  const TQ* Qw = Qb + (long)(wid * QBLK + r32) * LDQ + hi * 8;
#pragma unroll
  for (int d0 = 0; d0 < 8; ++d0) qr[d0] = SQ::tobf(SQ::ld8(Qw + d0 * 16));
  const int sr = tid >> 4, sc = (tid & 15) * 8, vst0 = v_st(sr, sc), vst1 = v_st(32 + sr, sc);
  const int vb0 = (int)(uintptr_t)V_lds + v_rd_base(lane);
  struct { typename St::T vs0, vs1, ks0, ks1; } sr_[SDEPTH];
#define SLOAD(i, k0) do { sr_[i].vs0 = St::ld8(&Vh[(long)((k0) + sr) * LDK + sc]); sr_[i].vs1 = St::ld8(&Vh[(long)((k0) + 32 + sr) * LDK + sc]); \
    sr_[i].ks0 = St::ld8(&Kh[(long)((k0) + sr) * LDK + sc]); sr_[i].ks1 = St::ld8(&Kh[(long)((k0) + 32 + sr) * LDK + sc]); } while (0)
#define SWRITE(b, i) do { *(bf16x8*)((char*)V_lds + (b) * SHM_V + vst0) = St::tobf(sr_[i].vs0);          \
    *(bf16x8*)((char*)V_lds + (b) * SHM_V + vst1) = St::tobf(sr_[i].vs1); int kc = sc * 2;               \
    *(bf16x8*)((char*)K_lds + (b) * SHM_K + KSWZ(sr, kc)) = St::tobf(sr_[i].ks0);                       \
    *(bf16x8*)((char*)K_lds + (b) * SHM_K + KSWZ(32 + sr, kc)) = St::tobf(sr_[i].ks1); } while (0)
#define SWAIT() do { if constexpr (SDEPTH == 2) asm volatile("s_waitcnt vmcnt(4)" ::: "memory"); else asm volatile("s_waitcnt vmcnt(0)" ::: "memory"); } while (0)
#define RESC(a) do { if (__any((a) < 1.f)) { if (hi == 0) al_l[r32] = (a); asm volatile("s_waitcnt lgkmcnt(0)" ::: "memory"); \
    for (int d = 0; d < 4; ++d) for (int r = 0; r < 16; ++r) o[d][r] *= al_l[crow(r, hi)]; } } while (0)
  f32x16 pA0, pA1, pB0, pB1; float mnA, mnB, alA, alB; bf16x8 pa0, pa1, pa2, pa3; const int NT = seq / KVBLK;
  constexpr int SE = 0, SO = SDEPTH - 1;
  SLOAD(SE, 0); asm volatile("s_waitcnt vmcnt(0)" ::: "memory"); SWRITE(0, SE); __syncthreads();
  qkt(pA0, pA1, K_lds, qr, r32, hi); partialSM(pA0, pA1, m_reg, mnA, alA);
  SLOAD(SO, KVBLK); if constexpr (SDEPTH == 2) { if (2 < NT) SLOAD(SE, 2 * KVBLK); }
  SWAIT(); SWRITE(1, SO); __syncthreads();
  for (int j = 1; j + 1 < NT; j += 2) {
    SBAR(); qkt(pB0, pB1, (bf16*)((char*)K_lds + SHM_K), qr, r32, hi);
    finishSM(pA0, pA1, alA, l_reg, pa0, pa1, pa2, pa3); SBAR();
    SLOAD(SO, (j + SDEPTH) * KVBLK); SBAR();
    pv_d0(o, vb0, pa0, pa1, pa2, pa3); partialSM(pB0, pB1, m_reg, mnB, alB);
    __syncthreads(); SWAIT(); SWRITE(0, SE);
    RESC(alB); __syncthreads();
    SBAR(); qkt(pA0, pA1, K_lds, qr, r32, hi);
    finishSM(pB0, pB1, alB, l_reg, pa0, pa1, pa2, pa3); SBAR();
    if (SDEPTH == 1 || j + 3 < NT) SLOAD(SE, (j + 1 + SDEPTH) * KVBLK); SBAR();
    pv_d0(o, vb0 + (int)SHM_V, pa0, pa1, pa2, pa3); partialSM(pA0, pA1, m_reg, mnA, alA);
    __syncthreads(); SWAIT(); SWRITE(1, SO);
    RESC(alA); __syncthreads();
  }
  SBAR(); qkt(pB0, pB1, (bf16*)((char*)K_lds + SHM_K), qr, r32, hi);
  finishSM(pA0, pA1, alA, l_reg, pa0, pa1, pa2, pa3); SBAR();
  pv_d0(o, vb0, pa0, pa1, pa2, pa3); partialSM(pB0, pB1, m_reg, mnB, alB);
  __syncthreads(); RESC(alB);
  finishSM(pB0, pB1, alB, l_reg, pa0, pa1, pa2, pa3); SBAR();
  pv_d0(o, vb0 + (int)SHM_V, pa0, pa1, pa2, pa3);
  if (hi == 0) li_l[r32] = l_reg; asm volatile("s_waitcnt lgkmcnt(0)" ::: "memory");
  float rli[16];
#pragma unroll
  for (int r = 0; r < 16; ++r) rli[r] = __builtin_amdgcn_rcpf(li_l[crow(r, hi)]);
  bf16* Ow = Ob + (long)(wid * QBLK) * LDO;
#pragma unroll
  for (int r = 0; r < 16; ++r) { int orow = crow(r, hi);
    for (int d0 = 0; d0 < 4; ++d0) Ow[(long)orow * LDO + d0 * 32 + r32] = (bf16)(cvtpk(o[d0][r] * rli[r], 0.f) & 0xffffu); }
#undef SLOAD
#undef SWRITE
#undef SWAIT
#undef RESC
}
}

#define LAS __attribute__((address_space(3)))
typedef unsigned short bf16;
typedef float f32x4 __attribute__((ext_vector_type(4)));
typedef unsigned v4u __attribute__((ext_vector_type(4)));
typedef unsigned v2u __attribute__((ext_vector_type(2)));
typedef short bf16x8 __attribute__((ext_vector_type(8)));

constexpr int NWAVES = 8, NTHR = 512;
constexpr int DM = 1024, NB = 32, SEQ = 2048, CTXL = 256, NLAT = NB * SEQ, NCTX = NB * CTXL, MT = NLAT + NCTX, FF = 2816, MIXIN = 2560, NQKV = 1536, SKV = SEQ + CTXL;
constexpr float LN_EPS = 1e-5f, RMS_EPS = 1e-6f;
constexpr size_t MiB = 1u << 20;
constexpr size_t WS_MOD = 1 * MiB, WS_ROPE = 3 * MiB, WS_WSGU = 4 * MiB, WS_WMIXIN = 5 * MiB, WS_WMIXOUT = 10 * MiB, WS_WFFNIN = 12 * MiB, WS_WFFNOUT = 34 * MiB,
                 WS_WQKV = 45 * MiB, WS_WAOUT = 48 * MiB, WS_STREAM = 50 * MiB, WS_H = 338 * MiB, WS_BIG = 482 * MiB, WS_END = 878 * MiB;
constexpr size_t BIG_K = 128 * MiB, BIG_V = 164 * MiB, BIG_O = 200 * MiB;
static_assert(WS_STREAM + (size_t)MT * DM * 4 <= WS_H && WS_H + (size_t)MT * DM * 2 <= WS_BIG && WS_BIG + (size_t)MT * FF * 2 <= WS_END, "ws map");
static_assert((size_t)NLAT * DM * 2 <= BIG_K && BIG_K + (size_t)NB * SKV * 256 * 2 <= BIG_V && BIG_V + (size_t)NB * SKV * 256 * 2 <= BIG_O, "ws map 2");
constexpr int LDS_BYTES = 147456;
constexpr int NPH = 17;

__device__ __forceinline__ float wave_sum(float v) {
#pragma unroll
    for (int o = 1; o < 64; o <<= 1) v += __shfl_xor(v, o);
    return v;
}
__device__ __forceinline__ unsigned pk2(float lo, float hi) { unsigned r; asm volatile("v_cvt_pk_bf16_f32 %0, %1, %2" : "=v"(r) : "v"(lo), "v"(hi)); return r; }
__device__ __forceinline__ float bflo(unsigned u) { return __uint_as_float(u << 16); }
__device__ __forceinline__ float bfhi(unsigned u) { return __uint_as_float(u & 0xffff0000u); }
__device__ __forceinline__ void unpack8(v4u r, float (&x)[8]) { x[0] = bflo(r.x); x[1] = bfhi(r.x); x[2] = bflo(r.y); x[3] = bfhi(r.y); x[4] = bflo(r.z); x[5] = bfhi(r.z); x[6] = bflo(r.w); x[7] = bfhi(r.w); }
__device__ __forceinline__ v4u pack8(const float (&x)[8]) { v4u w; w.x = pk2(x[0], x[1]); w.y = pk2(x[2], x[3]); w.z = pk2(x[4], x[5]); w.w = pk2(x[6], x[7]); return w; }

__device__ __forceinline__ int map_row(int kind, int n) {
    if (kind == 1) {
        if (n >= 512 && n < 1024) { const int q = n - 512; return 512 + 256 * (q >> 7) + (q & 127); }
        if (n >= 1024 && n < 1536) { const int q = n - 1024; return 512 + 256 * (q >> 7) + 128 + (q & 127); }
        return n;
    }
    if (kind == 2) { if (n < FF) return 256 * (n >> 7) + (n & 127); const int q = n - FF; return 256 * (q >> 7) + 128 + (q & 127); }
    return n;
}
__device__ __forceinline__ void transpose_item(const float* W, int K, int N, bf16* WT, int kind, LAS float* scr, int item, int lane) {
    const int nblk = N / 32, kb = item / nblk, nb = item % nblk, k0 = 64 * kb, n0 = 32 * nb;
#pragma unroll 8
    for (int i = 0; i < 32; ++i) { const int kk = 2 * i + (lane >> 5); scr[kk * 33 + (lane & 31)] = W[(size_t)(k0 + kk) * N + n0 + (lane & 31)]; }
    asm volatile("s_waitcnt lgkmcnt(0)" ::: "memory");
    const int c = lane & 7, pr0 = map_row(kind, n0);
#pragma unroll
    for (int j = 0; j < 4; ++j) { const int n = (lane >> 3) + 8 * j; const LAS float* s = scr + (8 * c) * 33 + n;
        v4u o; o.x = pk2(s[0 * 33], s[1 * 33]); o.y = pk2(s[2 * 33], s[3 * 33]); o.z = pk2(s[4 * 33], s[5 * 33]); o.w = pk2(s[6 * 33], s[7 * 33]);
        *(v4u*)(WT + (size_t)(pr0 + n) * K + k0 + 8 * c) = o; }
    asm volatile("s_waitcnt lgkmcnt(0)" ::: "memory");
}
__device__ __forceinline__ void adaln_task(int tk, const float* c, const float* c_ctx, const float* ada_w, const float* ada_b, float* mod, LAS float* T, int tid, int wave, int lane) {
    const int l = tk / 96, cb = tk % 96;
    const float* W = ada_w + (size_t)l * DM * 6144 + cb * 64 + lane;
    float acc[33];
#pragma unroll
    for (int bb = 0; bb < 33; ++bb) acc[bb] = 0.f;
    for (int half = 0; half < 2; ++half) {
        __syncthreads();
        for (int idx = tid; idx < 33 * 512; idx += NTHR) { const int bb = idx >> 9, kk = idx & 511, k = half * 512 + kk; const float cv = bb < 32 ? c[bb * DM + k] : c_ctx[k]; T[kk * 36 + bb] = cv / (1.0f + expf(-cv)); }
        __syncthreads();
        const int k0 = wave * 64;
#pragma unroll 4
        for (int kk = k0; kk < k0 + 64; ++kk) { const float wv = W[(size_t)(half * 512 + kk) * 6144];
#pragma unroll
            for (int bb = 0; bb < 33; ++bb) acc[bb] = fmaf(T[kk * 36 + bb], wv, acc[bb]); }
    }
    __syncthreads();
#pragma unroll
    for (int bb = 0; bb < 33; ++bb) T[(wave * 33 + bb) * 64 + lane] = acc[bb];
    __syncthreads();
    for (int o = tid; o < 33 * 64; o += NTHR) { const int bb = o >> 6, ln = o & 63; float s = ada_b[l * 6144 + cb * 64 + ln];
#pragma unroll
        for (int w = 0; w < 8; ++w) s += T[(w * 33 + bb) * 64 + ln];
        mod[((size_t)l * 33 + bb) * 6144 + cb * 64 + ln] = s; }
    __syncthreads();
}
__device__ __forceinline__ void rope_entry(int gt, float* rope) {
    const int pos = gt >> 5, i = gt & 31;
    const float inv = exp2f(-(float)i * 0.41524101186092029f), angf = (float)pos * inv;
    const double x = (double)angf, k = rint(x * 0.63661977236758134);
    double r = fma(-k, 1.5707963267948966, x); r = fma(-k, 6.123233995736766e-17, r);
    const double r2 = r * r;
    const double sn = r * (1.0 + r2 * (-1.0 / 6 + r2 * (1.0 / 120 + r2 * (-1.0 / 5040 + r2 * (1.0 / 362880 + r2 * (-1.0 / 39916800 + r2 * (1.0 / 6227020800.0)))))));
    const double cs = 1.0 + r2 * (-0.5 + r2 * (1.0 / 24 + r2 * (-1.0 / 720 + r2 * (1.0 / 40320 + r2 * (-1.0 / 3628800 + r2 * (1.0 / 479001600.0))))));
    const int q = ((int)k) & 3;
    const double co = q == 0 ? cs : q == 1 ? -sn : q == 2 ? -cs : sn, si = q == 0 ? sn : q == 1 ? cs : q == 2 ? -sn : -cs;
    rope[2 * gt] = (float)co; rope[2 * gt + 1] = (float)si;
}

__device__ __forceinline__ void mod_rows(const float* xl, const float* xc, const float* modl, bf16* h, int gw, int NGW, int lane) {
    for (int m = gw; m < MT; m += NGW) {
        const float* src = m < NLAT ? xl + (size_t)m * DM : xc + (size_t)(m - NLAT) * DM;
        const int bb = m < NLAT ? (m >> 11) : 32;
        const f32x4* xr = (const f32x4*)src + lane; const f32x4* sh = (const f32x4*)(modl + (size_t)bb * 6144) + lane; const f32x4* sc = (const f32x4*)(modl + (size_t)bb * 6144 + 1024) + lane;
        v2u* o = (v2u*)(h + (size_t)m * DM) + lane;
#pragma unroll
        for (int j = 0; j < 4; ++j) { const f32x4 v = xr[64 * j], a = sc[64 * j], b = sh[64 * j]; const f32x4 y = v * (a + 1.0f) + b; v2u w; w.x = pk2(y[0], y[1]); w.y = pk2(y[2], y[3]); o[64 * j] = w; }
    }
}
__device__ __forceinline__ void ln_rows(const float* src, float* dst, int rows, const float* g, const float* b, const float* modn, int sh_off, int sc_off, bf16* h, int gw, int NGW, int lane) {
    f32x4 gg[4], bv[4];
#pragma unroll
    for (int j = 0; j < 4; ++j) { gg[j] = ((const f32x4*)g)[lane + 64 * j]; bv[j] = ((const f32x4*)b)[lane + 64 * j]; }
    for (int m = gw; m < rows; m += NGW) {
        const f32x4* xr = (const f32x4*)(src + (size_t)m * DM) + lane;
        f32x4 v[4]; float s = 0.f;
#pragma unroll
        for (int j = 0; j < 4; ++j) { v[j] = xr[64 * j]; s += (v[j][0] + v[j][1]) + (v[j][2] + v[j][3]); }
        const float mean = wave_sum(s) * (1.f / DM); float s2 = 0.f;
#pragma unroll
        for (int j = 0; j < 4; ++j) { v[j] = v[j] - mean; s2 += (v[j][0] * v[j][0] + v[j][1] * v[j][1]) + (v[j][2] * v[j][2] + v[j][3] * v[j][3]); }
        const float rstd = 1.0f / sqrtf(wave_sum(s2) * (1.f / DM) + LN_EPS);
        f32x4* o = (f32x4*)(dst + (size_t)m * DM) + lane;
        const int bb = m < NLAT ? (m >> 11) : 32;
#pragma unroll
        for (int j = 0; j < 4; ++j) { const f32x4 y = v[j] * rstd * gg[j] + bv[j]; o[64 * j] = y;
            if (h) { const f32x4 a = ((const f32x4*)(modn + (size_t)bb * 6144 + sc_off))[lane + 64 * j], c = ((const f32x4*)(modn + (size_t)bb * 6144 + sh_off))[lane + 64 * j];
                const f32x4 hv = y * (a + 1.0f) + c; v2u w; w.x = pk2(hv[0], hv[1]); w.y = pk2(hv[2], hv[3]); ((v2u*)(h + (size_t)m * DM))[lane + 64 * j] = w; } }
    }
}

__device__ __forceinline__ void mixer_core(const bf16* P, bf16* Y, const float* conv_w, const float* sln_g, const float* sln_b, const bf16* Wsg, const float* sgu_b,
                                           LAS unsigned char* lds, int G, int bid, int tid) {
    const int lane = tid & 63, wave = tid >> 6, fr = lane & 15, fq = lane >> 4;
    for (long idx = (long)bid * NTHR + tid; idx < (long)MT * 64; idx += (long)G * NTHR) {
        const int row = (int)(idx >> 6), c8 = (int)(idx & 63) * 8;
        int pos, len; if (row < NLAT) { pos = row & (SEQ - 1); len = SEQ; } else { pos = (row - NLAT) & (CTXL - 1); len = CTXL; }
        const bf16* pr = P + (size_t)row * 2048;
        const v4u gb = *(const v4u*)(pr + c8), z0 = *(const v4u*)(pr + 512 + c8);
        v4u zm = (v4u){0u, 0u, 0u, 0u}, zp = (v4u){0u, 0u, 0u, 0u};
        if (pos > 0) zm = *(const v4u*)(pr - 2048 + 512 + c8);
        if (pos < len - 1) zp = *(const v4u*)(pr + 2048 + 512 + c8);
        float g_[8], a_[8], m_[8], p_[8], w0[8], w1[8], w2[8], y[8];
        unpack8(gb, g_); unpack8(z0, a_); unpack8(zm, m_); unpack8(zp, p_);
#pragma unroll
        for (int j = 0; j < 8; ++j) { w0[j] = conv_w[c8 + j]; w1[j] = conv_w[512 + c8 + j]; w2[j] = conv_w[1024 + c8 + j]; }
#pragma unroll
        for (int j = 0; j < 8; ++j) y[j] = g_[j] * (w0[j] * m_[j] + w1[j] * a_[j] + w2[j] * p_[j]);
        *(v4u*)(Y + (size_t)row * DM + c8) = pack8(y);
    }
    LAS float* stats = (LAS float*)lds;
    LAS bf16* vnt = (LAS bf16*)(lds + 1024) + wave * (32 * 136);
    for (int ch = bid; ch < MT / 128; ch += G) {
        const int row0 = ch * 128;
        __syncthreads();
        for (int r = 0; r < 16; ++r) { const int rr = wave * 16 + r;
            const v4u raw = *(const v4u*)(P + (size_t)(row0 + rr) * 2048 + 1536 + lane * 8); float x[8]; unpack8(raw, x);
            float s = 0.f;
#pragma unroll
            for (int j = 0; j < 8; ++j) s += x[j];
            const float mean = wave_sum(s) * (1.f / 512.f); float q = 0.f;
#pragma unroll
            for (int j = 0; j < 8; ++j) { const float d = x[j] - mean; q += d * d; }
            const float rstd = 1.0f / sqrtf(wave_sum(q) * (1.f / 512.f) + LN_EPS);
            if (lane == 0) { stats[2 * rr] = mean; stats[2 * rr + 1] = rstd; } }
        __syncthreads();
        const int g = wave;
        for (int dh = 0; dh < 2; ++dh) {
            const int cbase = 64 * g + 32 * dh, part = lane & 3, ql = lane >> 2;
            float lg[8], lb[8];
#pragma unroll
            for (int j = 0; j < 8; ++j) { lg[j] = sln_g[cbase + 8 * part + j]; lb[j] = sln_b[cbase + 8 * part + j]; }
#pragma unroll 2
            for (int it = 0; it < 8; ++it) { const int q = 16 * it + ql;
                const v4u raw = *(const v4u*)(P + (size_t)(row0 + q) * 2048 + 1536 + cbase + 8 * part); float x[8]; unpack8(raw, x);
                const float mean = stats[2 * q], rstd = stats[2 * q + 1];
#pragma unroll
                for (int j = 0; j < 8; j += 2) { const unsigned w = pk2((x[j] - mean) * rstd * lg[j] + lb[j], (x[j + 1] - mean) * rstd * lg[j + 1] + lb[j + 1]);
                    vnt[(8 * part + j) * 136 + q] = (bf16)(w & 0xffffu); vnt[(8 * part + j + 1) * 136 + q] = (bf16)(w >> 16); } }
            asm volatile("s_waitcnt lgkmcnt(0)" ::: "memory");
            f32x4 acc[2][8];
#pragma unroll
            for (int dt = 0; dt < 2; ++dt)
#pragma unroll
                for (int pt = 0; pt < 8; ++pt) acc[dt][pt] = (f32x4){0.f, 0.f, 0.f, 0.f};
#pragma unroll 1
            for (int ks = 0; ks < 4; ++ks) {
                bf16x8 af[2];
#pragma unroll
                for (int dt = 0; dt < 2; ++dt) af[dt] = *(const LAS bf16x8*)(vnt + (16 * dt + fr) * 136 + 32 * ks + 8 * fq);
#pragma unroll
                for (int pt = 0; pt < 8; ++pt) { const bf16x8 bw = *(const bf16x8*)(Wsg + ((size_t)g * 128 + 16 * pt + fr) * 128 + 32 * ks + 8 * fq);
#pragma unroll
                    for (int dt = 0; dt < 2; ++dt) acc[dt][pt] = __builtin_amdgcn_mfma_f32_16x16x32_bf16(af[dt], bw, acc[dt][pt], 0, 0, 0); }
            }
#pragma unroll
            for (int pt = 0; pt < 8; ++pt) { const int p = 16 * pt + fr; const float bs = sgu_b[g * 128 + p]; const size_t row = (size_t)row0 + p;
#pragma unroll
                for (int dt = 0; dt < 2; ++dt) { const int c = cbase + 16 * dt + 4 * fq; const v2u gu = *(const v2u*)(P + row * 2048 + 1024 + c);
                    v2u w; w.x = pk2(bflo(gu.x) * (acc[dt][pt][0] + bs), bfhi(gu.x) * (acc[dt][pt][1] + bs)); w.y = pk2(bflo(gu.y) * (acc[dt][pt][2] + bs), bfhi(gu.y) * (acc[dt][pt][3] + bs));
                    *(v2u*)(Y + row * DM + 512 + c) = w; } }
            asm volatile("s_waitcnt lgkmcnt(0)" ::: "memory");
        }
    }
}

__device__ __forceinline__ v4u norm_rope_chunk(v4u raw, int t, const float* gain, const float* rope, int lane) {
    const int l16 = lane & 15;
    float x[8]; unpack8(raw, x);
    float ss = 0.f;
#pragma unroll
    for (int j = 0; j < 8; ++j) ss += x[j] * x[j];
    ss += __shfl_xor(ss, 1); ss += __shfl_xor(ss, 2); ss += __shfl_xor(ss, 4); ss += __shfl_xor(ss, 8);
    const float rinv = 1.0f / sqrtf(ss * (1.f / 128.f) + RMS_EPS);
    float xn[8], pn[8], o[8];
#pragma unroll
    for (int j = 0; j < 8; ++j) xn[j] = x[j] * rinv * gain[8 * l16 + j];
#pragma unroll
    for (int j = 0; j < 8; ++j) pn[j] = __shfl_xor(xn[j], 4);
    const int a = l16 >> 3, s = (l16 >> 2) & 1, i0 = 8 * (l16 & 3);
    const int tt = t >= 0 ? t : 0, pa = a ? (tt & 63) : (tt >> 6);
    const f32x4* rp = (const f32x4*)(rope + (size_t)(pa * 32 + i0) * 2);
#pragma unroll
    for (int j2 = 0; j2 < 4; ++j2) { const f32x4 cs = rp[j2];
        const float r0 = s ? xn[2 * j2] * cs[0] + pn[2 * j2] * cs[1] : xn[2 * j2] * cs[0] - pn[2 * j2] * cs[1];
        const float r1 = s ? xn[2 * j2 + 1] * cs[2] + pn[2 * j2 + 1] * cs[3] : xn[2 * j2 + 1] * cs[2] - pn[2 * j2 + 1] * cs[3];
        o[2 * j2] = t >= 0 ? r0 : xn[2 * j2]; o[2 * j2 + 1] = t >= 0 ? r1 : xn[2 * j2 + 1]; }
    return pack8(o);
}
__device__ __forceinline__ void qk_norm_rope(bf16* Q, bf16* Kb, const float* q_g, const float* k_g, const float* rope, int gw, int NGW, int lane) {
    for (int r = gw; r < NLAT; r += NGW) {
        v4u* p = (v4u*)(Q + (size_t)r * DM) + lane; const int t = r & (SEQ - 1);
        const v4u a = p[0], b = p[64];
        p[0] = norm_rope_chunk(a, t, q_g, rope, lane); p[64] = norm_rope_chunk(b, t, q_g, rope, lane);
    }
    for (int rp = gw; rp < NB * SKV / 2; rp += NGW) {
        const int kr = 2 * rp + (lane >> 5), pos = kr % SKV; v4u* p = (v4u*)(Kb + (size_t)kr * 256) + (lane & 31);
        const v4u a = p[0];
        p[0] = norm_rope_chunk(a, pos < SEQ ? pos : -1, k_g, rope, lane);
    }
}

struct Args { const float* in[21]; float* out; unsigned char* ws; int ph_lo, ph_hi; };
__global__ void __launch_bounds__(NTHR, 2) fwd_megakernel(Args a) {
    extern __shared__ __attribute__((aligned(16))) unsigned char lds_raw[];
    cg::grid_group grid = cg::this_grid();
    LAS unsigned char* lds = (LAS unsigned char*)lds_raw;
    const int tid = threadIdx.x, lane = tid & 63, wave = __builtin_amdgcn_readfirstlane(tid >> 6);
    const int G = gridDim.x, bid = blockIdx.x, gw = bid * NWAVES + wave, NGW = G * NWAVES;
    const int lo = a.ph_lo, hi = a.ph_hi;
    unsigned char* ws = a.ws;
    const float *x_in = a.in[0], *c_in = a.in[1], *ctx_in = a.in[2], *cctx_in = a.in[3], *ada_w = a.in[4], *ada_b = a.in[5], *ln_g = a.in[6], *ln_b = a.in[7],
                *ffn_w_in = a.in[8], *ffn_w_out = a.in[9], *mix_w_in = a.in[10], *conv_w = a.in[11], *sgu_ln_g = a.in[12], *sgu_ln_b = a.in[13], *sgu_w = a.in[14], *sgu_b = a.in[15],
                *mix_w_out = a.in[16], *attn_w_qkv = a.in[17], *q_norm_g = a.in[18], *k_norm_g = a.in[19], *attn_w_out = a.in[20];
    float* mod = (float*)(ws + WS_MOD); float* rope = (float*)(ws + WS_ROPE);
    bf16 *Wsg = (bf16*)(ws + WS_WSGU), *Wmixin = (bf16*)(ws + WS_WMIXIN), *Wmixout = (bf16*)(ws + WS_WMIXOUT), *Wffnin = (bf16*)(ws + WS_WFFNIN), *Wffnout = (bf16*)(ws + WS_WFFNOUT),
         *Wqkv = (bf16*)(ws + WS_WQKV), *Waout = (bf16*)(ws + WS_WAOUT);
    float* stream = (float*)(ws + WS_STREAM);
    bf16* H = (bf16*)(ws + WS_H);
    bf16* BIG = (bf16*)(ws + WS_BIG);
    bf16 *Qb = BIG, *Kb = (bf16*)(ws + WS_BIG + BIG_K), *Vb = (bf16*)(ws + WS_BIG + BIG_V), *Ob = (bf16*)(ws + WS_BIG + BIG_O);
#ifndef PHASE_MASK
#define PHASE_MASK 0x1ffff
#endif
#define IN(k) ((((PHASE_MASK) >> (k)) & 1) && lo <= (k) && (k) < hi)
#define SEAM(k) do { if (IN(k) && IN((k) + 1)) grid.sync(); } while (0)

    if (IN(0)) {
        for (int tk = bid; tk < 192; tk += G) adaln_task(tk, c_in, cctx_in, ada_w, ada_b, mod, (LAS float*)lds, tid, wave, lane);
        __syncthreads();
        { const int gt = bid * NTHR + tid; if (gt < 64 * 32) rope_entry(gt, rope); }
        for (int i = bid * NTHR + tid; i < 8 * 128 * 128 / 2; i += G * NTHR) ((unsigned*)Wsg)[i] = pk2(sgu_w[2 * i], sgu_w[2 * i + 1]);
        LAS float* scr = (LAS float*)(lds + wave * 16384);
        constexpr int I_MI = (DM / 64) * (MIXIN / 32), I_MO = (DM / 64) * (DM / 32), I_FI = (DM / 64) * (2 * FF / 32), I_FO = (FF / 64) * (DM / 32), I_QKV = (DM / 64) * (NQKV / 32), I_AO = I_MO;
        constexpr int NITEMS = I_MI + I_MO + 2 * I_FI + 2 * I_FO + I_QKV + I_AO;
        for (int it = gw; it < NITEMS; it += NGW) {
            int r = it;
            if (r < I_MI) { transpose_item(mix_w_in, DM, MIXIN, Wmixin, 1, scr, r, lane); continue; } r -= I_MI;
            if (r < I_MO) { transpose_item(mix_w_out, DM, DM, Wmixout, 0, scr, r, lane); continue; } r -= I_MO;
            if (r < I_FI) { transpose_item(ffn_w_in, DM, 2 * FF, Wffnin, 2, scr, r, lane); continue; } r -= I_FI;
            if (r < I_FI) { transpose_item(ffn_w_in + (size_t)DM * 2 * FF, DM, 2 * FF, Wffnin + (size_t)2 * FF * DM, 2, scr, r, lane); continue; } r -= I_FI;
            if (r < I_FO) { transpose_item(ffn_w_out, FF, DM, Wffnout, 0, scr, r, lane); continue; } r -= I_FO;
            if (r < I_FO) { transpose_item(ffn_w_out + (size_t)FF * DM, FF, DM, Wffnout + (size_t)DM * FF, 0, scr, r, lane); continue; } r -= I_FO;
            if (r < I_QKV) { transpose_item(attn_w_qkv, DM, NQKV, Wqkv, 0, scr, r, lane); continue; } r -= I_QKV;
            transpose_item(attn_w_out, DM, DM, Waout, 0, scr, r, lane);
        }
        __syncthreads();
    }
    SEAM(0);
    if (IN(1)) mod_rows(x_in, ctx_in, mod, H, gw, NGW, lane);
    SEAM(1);

    if (IN(2)) { pg8::Gemm g{H, Wmixin, MT, MIXIN, DM}; pg8::StaticOrder S; S.init(MT, MIXIN, G, bid); pg8::EpiMixIn E{BIG};
        pg8::gemm_phase<pg8::EpiMixIn, pg8::StaticOrder, true, true>(lds, g, S, E); }
    SEAM(2);
    if (IN(3)) mixer_core(BIG, H, conv_w, sgu_ln_g, sgu_ln_b, Wsg, sgu_b, lds, G, bid, tid);
    SEAM(3);
#define LAYER_TAIL(L_, PB, M_, AOP, WOUT, SRC_LAT, SRC_CTX)                                                                                                         \
    if (IN(4 + PB)) { pg8::Gemm g{AOP, WOUT, M_, DM, DM}; pg8::StaticOrder S; S.init(M_, DM, G, bid);                                                               \
        pg8::EpiResid E{SRC_LAT, SRC_CTX, stream, mod + (size_t)L_ * 33 * 6144 + 2048};                                                                             \
        pg8::gemm_phase<pg8::EpiResid, pg8::StaticOrder, true, true>(lds, g, S, E); }                                                                               \
    SEAM(4 + PB);                                                                                                                                                   \
    if (IN(5 + PB)) ln_rows(stream, stream, M_, ln_g + (size_t)(2 * L_) * DM, ln_b + (size_t)(2 * L_) * DM, mod + (size_t)L_ * 33 * 6144, 3072, 4096, H, gw, NGW, lane); \
    SEAM(5 + PB);                                                                                                                                                   \
    if (IN(6 + PB)) { pg8::Gemm g{H, Wffnin + (size_t)L_ * 2 * FF * DM, M_, 2 * FF, DM}; pg8::StaticOrder S; S.init(M_, 2 * FF, G, bid); pg8::EpiSwiglu E{BIG};     \
        pg8::gemm_phase<pg8::EpiSwiglu, pg8::StaticOrder, true, true>(lds, g, S, E); }                                                                              \
    SEAM(6 + PB);                                                                                                                                                   \
    if (IN(7 + PB)) { pg8::Gemm g{BIG, Wffnout + (size_t)L_ * DM * FF, M_, DM, FF}; pg8::StaticOrder S; S.init(M_, DM, G, bid);                                     \
        pg8::EpiResid E{stream, stream + (size_t)NLAT * DM, stream, mod + (size_t)L_ * 33 * 6144 + 5120};                                                           \
        pg8::gemm_phase<pg8::EpiResid, pg8::StaticOrder, true, true>(lds, g, S, E); }                                                                               \
    SEAM(7 + PB);
    LAYER_TAIL(0, 0, MT, H, Wmixout, x_in, ctx_in)
    if (IN(8)) ln_rows(stream, stream, MT, ln_g + DM, ln_b + DM, mod + (size_t)33 * 6144, 0, 1024, H, gw, NGW, lane);
    SEAM(8);
    if (IN(9)) { pg8::Gemm g{H, Wqkv, MT, NQKV, DM}; pg8::QkvOrder S; S.init(NLAT, NQKV, G, bid); pg8::EpiQKV E{Qb, Kb, Vb};
        pg8::gemm_phase<pg8::EpiQKV, pg8::QkvOrder, true, true>(lds, g, S, E); }
    SEAM(9);
    if (IN(10)) qk_norm_rope(Qb, Kb, q_norm_g, k_norm_g, rope, gw, NGW, lane);
    SEAM(10);
    if (IN(11)) {
        for (int L = bid; L < NB * 8 * (SEQ / 256); L += G) {
            const int round = L >> 8, c = L & 255, xq = c & 7, s = c >> 3;
            const int b = 4 * round + (xq >> 1), kvh = xq & 1, h = 4 * kvh + (s >> 3), qb = s & 7;
            const size_t qoff = ((size_t)b * SEQ + 256 * qb) * DM + 128 * h, koff = (size_t)b * SKV * 256 + 128 * kvh;
            att::attn_dense_body<att::bf16>(Qb + qoff, Kb + koff, Vb + koff, Ob + qoff, SKV, (char*)lds_raw);
            __syncthreads();
        }
    }
    SEAM(11);
    LAYER_TAIL(1, 8, NLAT, Ob, Waout, stream, stream + (size_t)NLAT * DM)
    if (IN(16)) ln_rows(stream, a.out, NLAT, ln_g + 3 * DM, ln_b + 3 * DM, nullptr, 0, 0, nullptr, gw, NGW, lane);
#undef LAYER_TAIL
#undef IN
#undef SEAM
}

#ifndef MK_PER_PHASE
#define MK_PER_PHASE 0
#endif
extern "C" void kernel_launch(void* const* d_in, const int* in_sizes, int n_in, void* d_out, int out_size, void* d_ws, size_t ws_size, hipStream_t stream) {
    static int grid = 0;
    if (grid == 0) {
        if (n_in != 21 || in_sizes[0] != NLAT * DM || out_size != NLAT * DM || ws_size < WS_END) {
            fprintf(stderr, "kernel_launch: unexpected shapes: n_in %d in0 %d out %d ws %zu (need %zu)\n", n_in, n_in > 0 ? in_sizes[0] : -1, out_size, ws_size, (size_t)WS_END); grid = -1; return; }
        int dev = 0, cus = 0, per_cu = 0;
        if (hipGetDevice(&dev) != hipSuccess || hipDeviceGetAttribute(&cus, hipDeviceAttributeMultiprocessorCount, dev) != hipSuccess) { fprintf(stderr, "kernel_launch: device query failed\n"); grid = -1; return; }
        if (hipFuncSetAttribute((const void*)fwd_megakernel, hipFuncAttributeMaxDynamicSharedMemorySize, LDS_BYTES) != hipSuccess) { fprintf(stderr, "kernel_launch: hipFuncSetAttribute failed\n"); grid = -1; return; }
        if (hipOccupancyMaxActiveBlocksPerMultiprocessor(&per_cu, (const void*)fwd_megakernel, NTHR, LDS_BYTES) != hipSuccess || per_cu < 1) { fprintf(stderr, "kernel_launch: occupancy query says %d blocks per CU\n", per_cu); per_cu = 1; }
        (void)hipGetLastError();
        grid = cus * per_cu;
        fprintf(stderr, "kernel_launch: %d CUs x %d = grid %d\n", cus, per_cu, grid);
    }
    if (grid < 0) return;
    Args a{};
    for (int i = 0; i < 21; ++i) a.in[i] = (const float*)d_in[i];
    a.out = (float*)d_out; a.ws = (unsigned char*)d_ws;
#if MK_PER_PHASE
    for (int ph = 0; ph < NPH; ++ph) { a.ph_lo = ph; a.ph_hi = ph + 1; hipLaunchKernelGGL(fwd_megakernel, dim3(grid), dim3(NTHR), LDS_BYTES, stream, a); }
#else
    a.ph_lo = 0; a.ph_hi = NPH;
    void* args[] = {&a};
    const hipError_t e = hipLaunchCooperativeKernel((const void*)fwd_megakernel, dim3(grid), dim3(NTHR), args, LDS_BYTES, stream);
    if (e != hipSuccess) fprintf(stderr, "kernel_launch: cooperative launch failed: %s (grid %d)\n", hipGetErrorString(e), grid);
#endif
}
```

```cpp
#include <hip/hip_runtime.h>
#include <hip/hip_cooperative_groups.h>
#include <cstdio>
#include <cstdint>
namespace cg = cooperative_groups;

namespace pg8 {
#define PG8_LAS __attribute__((address_space(3)))
typedef unsigned short bf16_t;
typedef short bf16x8 __attribute__((ext_vector_type(8)));
typedef float f32x4 __attribute__((ext_vector_type(4)));
typedef unsigned u32x4 __attribute__((ext_vector_type(4)));
constexpr int BM = 256, BK = 64, HALF = 128, HTB = HALF * BK * 2  , STAGE_BYTES = 8 * HTB, NXCD = 8, WGM = 8;

__host__ __device__ __forceinline__ int lds_byte(int r, int c) { const int st = (r >> 4) * 2 + (c >> 5), rr = r & 15, cc = c & 31, ob = rr * 64 + cc * 2; return st * 1024 + (ob ^ (((ob >> 9) & 1) << 5)); }
__host__ __device__ __forceinline__ void stage_rc(int b, int& R, int& C) { const int st = b / 1024, sb = b % 1024, swz = sb ^ (((sb >> 9) & 1) << 5); R = (st >> 1) * 16 + swz / 64; C = (st & 1) * 32 + (swz % 64) / 2; }
__host__ __device__ __forceinline__ int perm32(int rho) { const int n = rho >> 4, i = rho & 15; return 8 * (i >> 2) + 4 * n + (i & 3); }

struct Unit { int pm, pn; };
struct Gemm { const bf16_t* A; const bf16_t* Bt; int M, N, K; };

struct StaticOrder {
    int nM, nN, nwg, G, c;
    __host__ __device__ void init(int M, int N, int G_, int c_) { nM = M / BM; nN = N / BM; nwg = nM * nN; G = G_; c = c_; }
    __host__ __device__ bool next(int i, Unit& u) const {
        const long L = (long)i * G + c; if (L >= nwg) return false;
        int wgid = (int)L; { const int q = nwg / NXCD, r = nwg % NXCD, xcd = wgid % NXCD, off = wgid / NXCD; wgid = (xcd < r ? xcd * (q + 1) : r * (q + 1) + (xcd - r) * q) + off; }
        const int nig = WGM * nN, gid = wgid / nig, fm = gid * WGM, gsz = (nM - fm) < WGM ? (nM - fm) : WGM;
        u.pm = fm + ((wgid % nig) % gsz); u.pn = (wgid % nig) / gsz; return true;
    }
    __device__ __forceinline__ void a_ready(const Unit&) const {}
    __device__ __forceinline__ void done(const Unit&) const {}
};

__device__ __forceinline__ unsigned cvt_pk_bf16(float lo, float hi) { unsigned r; asm volatile("v_cvt_pk_bf16_f32 %0, %1, %2" : "=v"(r) : "v"(lo), "v"(hi)); return r; }
typedef float f32x2 __attribute__((ext_vector_type(2)));
__device__ __forceinline__ f32x2 gelu_pk(f32x2 v) {
    const f32x2 av = __builtin_elementwise_abs(v), d = av * 0.2316418882f + 1.0f;
    f32x2 t; t.x = __builtin_amdgcn_rcpf(d.x); t.y = __builtin_amdgcn_rcpf(d.y);
    f32x2 q = t * 0.5307027145f + (-0.7265760135f); q = q * t + 0.7107068705f; q = q * t + (-0.142248368f); q = q * t + 0.127414796f; q = q * t;
    const f32x2 s = (v * v) * (-0.72134752044f);
    f32x2 e; e.x = __builtin_amdgcn_exp2f(s.x); e.y = __builtin_amdgcn_exp2f(s.y);
    const f32x2 m = v * (q * e), r = v - m;
    f32x2 o; o.x = v.x < 0.f ? m.x : r.x; o.y = v.y < 0.f ? m.y : r.y; return o;
}

constexpr int DM = 1024;
constexpr float ALPHA_RES = 1.4142135623730951f;
__device__ __forceinline__ void st_bf8(bf16_t* p, f32x4 v0, f32x4 v1) {
    u32x4 w; w.x = cvt_pk_bf16(v0[0], v0[1]); w.y = cvt_pk_bf16(v0[2], v0[3]); w.z = cvt_pk_bf16(v1[0], v1[1]); w.w = cvt_pk_bf16(v1[2], v1[3]);
    *(u32x4*)p = w;
}
__device__ __forceinline__ f32x4 gelu4(f32x4 v) { f32x2 a = gelu_pk((f32x2){v[0], v[1]}), b = gelu_pk((f32x2){v[2], v[3]}); return (f32x4){a.x, a.y, b.x, b.y}; }
__device__ __forceinline__ float silu1(float g) { return g * __builtin_amdgcn_rcpf(1.0f + __builtin_amdgcn_exp2f(-1.4426950408889634f * g)); }
__device__ __forceinline__ f32x4 swiglu4(f32x4 g, f32x4 u) { return (f32x4){silu1(g[0]) * u[0], silu1(g[1]) * u[1], silu1(g[2]) * u[2], silu1(g[3]) * u[3]}; }

struct EpiMixIn {
    static constexpr bool PERM = true, AFTER_DRAIN = false;
    bf16_t* P;
    __device__ __forceinline__ void operator()(const f32x4 (&acc)[2][2][4][2], const Unit& u, int wr, int wc, int fr, int fq) const {
        const int row0 = u.pm * BM + wr * 64 + fr, cw = wc * 32 + 8 * fq;
        if (u.pn < 2) {
#pragma unroll
            for (int ai = 0; ai < 2; ++ai)
#pragma unroll
                for (int m = 0; m < 4; ++m) { bf16_t* rowp = P + (size_t)(row0 + ai * HALF + m * 16) * 2048 + u.pn * 256 + cw;
#pragma unroll
                    for (int bj = 0; bj < 2; ++bj) st_bf8(rowp + bj * HALF, acc[ai][bj][m][0], acc[ai][bj][m][1]); }
        } else if (u.pn < 6) {
#pragma unroll
            for (int ai = 0; ai < 2; ++ai)
#pragma unroll
                for (int m = 0; m < 4; ++m) { bf16_t* rowp = P + (size_t)(row0 + ai * HALF + m * 16) * 2048 + 512 + (u.pn - 2) * 128 + cw;
                    st_bf8(rowp, acc[ai][0][m][0] * acc[ai][1][m][0], acc[ai][0][m][1] * acc[ai][1][m][1]); }
        } else {
#pragma unroll
            for (int ai = 0; ai < 2; ++ai)
#pragma unroll
                for (int m = 0; m < 4; ++m) { bf16_t* rowp = P + (size_t)(row0 + ai * HALF + m * 16) * 2048 + 1024 + (u.pn - 6) * 256 + cw;
#pragma unroll
                    for (int bj = 0; bj < 2; ++bj) st_bf8(rowp + bj * HALF, gelu4(acc[ai][bj][m][0]), gelu4(acc[ai][bj][m][1])); }
        }
    }
};
struct EpiSwiglu {
    static constexpr bool PERM = true, AFTER_DRAIN = false;
    bf16_t* H;
    __device__ __forceinline__ void operator()(const f32x4 (&acc)[2][2][4][2], const Unit& u, int wr, int wc, int fr, int fq) const {
        const int row0 = u.pm * BM + wr * 64 + fr, cw = wc * 32 + 8 * fq;
#pragma unroll
        for (int ai = 0; ai < 2; ++ai)
#pragma unroll
            for (int m = 0; m < 4; ++m) { bf16_t* rowp = H + (size_t)(row0 + ai * HALF + m * 16) * 2816 + u.pn * 128 + cw;
                st_bf8(rowp, swiglu4(acc[ai][0][m][0], acc[ai][1][m][0]), swiglu4(acc[ai][0][m][1], acc[ai][1][m][1])); }
    }
};
struct EpiResid {
    static constexpr bool PERM = false, AFTER_DRAIN = false;
    const float* src_lat; const float* src_ctx; float* dst; const float* gate;
    __device__ __forceinline__ void operator()(const f32x4 (&acc)[2][2][4][2], const Unit& u, int wr, int wc, int fr, int fq) const {
        const int bb = u.pm < 256 ? (u.pm >> 3) : 32;
        const int col0 = u.pn * BM + wc * 32 + 4 * fq, r_in = wr * 64 + fr;
        const float* gp = gate + (size_t)bb * 6144 + col0;
        const float* sbase = (u.pm < 256 ? src_lat + (size_t)u.pm * BM * DM : src_ctx + (size_t)(u.pm - 256) * BM * DM) + (size_t)r_in * DM + col0;
        float* dbase = dst + (size_t)u.pm * BM * DM + (size_t)r_in * DM + col0;
#pragma unroll
        for (int bj = 0; bj < 2; ++bj)
#pragma unroll
            for (int n = 0; n < 2; ++n) { const f32x4 gv = *(const f32x4*)(gp + bj * HALF + n * 16);
#pragma unroll
                for (int ai = 0; ai < 2; ++ai) {
#pragma unroll
                    for (int m = 0; m < 4; ++m) { const int off = (ai * HALF + m * 16) * DM + bj * HALF + n * 16; const f32x4 sv = *(const f32x4*)(sbase + off);
                        *(f32x4*)(dbase + off) = sv * ALPHA_RES + gv * acc[ai][bj][m][n]; }
                    asm volatile("" ::: "memory"); } }
    }
};
struct EpiGateY {
    static constexpr bool PERM = true, AFTER_DRAIN = false;
    bf16_t* YG; const float* gate;
    __device__ __forceinline__ void operator()(const f32x4 (&acc)[2][2][4][2], const Unit& u, int wr, int wc, int fr, int fq) const {
        const int bb = u.pm < 256 ? (u.pm >> 3) : 32, cw = wc * 32 + 8 * fq;
        const float* gp = gate + (size_t)bb * 6144 + u.pn * BM + cw;
        f32x4 g0[2], g1[2];
#pragma unroll
        for (int bj = 0; bj < 2; ++bj) { g0[bj] = *(const f32x4*)(gp + bj * HALF); g1[bj] = *(const f32x4*)(gp + bj * HALF + 4); }
#pragma unroll
        for (int ai = 0; ai < 2; ++ai)
#pragma unroll
            for (int m = 0; m < 4; ++m) { bf16_t* rowp = YG + (size_t)(u.pm * BM + wr * 64 + fr + ai * HALF + m * 16) * DM + u.pn * BM + cw;
#pragma unroll
                for (int bj = 0; bj < 2; ++bj) st_bf8(rowp + bj * HALF, acc[ai][bj][m][0] * g0[bj], acc[ai][bj][m][1] * g1[bj]); }
    }
};
struct ResidOrder {
    int c, nctx;
    __device__ bool next(int i, Unit& u) const {
        int j = i;
        if (c < nctx) { if (j == 0) { u.pm = 256 + (c >> 2); u.pn = c & 3; return true; } j -= 1; }
        if (j >= 4) return false;
        u.pm = c; u.pn = j; return true;
    }
    __device__ __forceinline__ void a_ready(const Unit&) const {}
    __device__ __forceinline__ void done(const Unit&) const {}
};
struct QkvOrder : StaticOrder {
    __device__ bool next(int i, Unit& u) const {
        const long L = (long)i * G + c;
        if (L < nwg) return StaticOrder::next(i, u);
        const int j = (int)(L - nwg); if (j >= 64) return false;
        u.pm = 256 + (j & 31); u.pn = 4 + (j >> 5); return true;
    }
};
struct EpiQKV {
    static constexpr bool PERM = true, AFTER_DRAIN = false;
    bf16_t* Q; bf16_t* Kb; bf16_t* Vb;
    __device__ __forceinline__ void operator()(const f32x4 (&acc)[2][2][4][2], const Unit& u, int wr, int wc, int fr, int fq) const {
        const int cw = wc * 32 + 8 * fq, r_in = wr * 64 + fr;
        constexpr int pn_k = 4; const bool is_ctx = u.pm >= 256;
        if (u.pn < pn_k) {
#pragma unroll
            for (int ai = 0; ai < 2; ++ai)
#pragma unroll
                for (int m = 0; m < 4; ++m) { bf16_t* rowp = Q + (size_t)(u.pm * BM + r_in + ai * HALF + m * 16) * 1024 + u.pn * 256 + cw;
#pragma unroll
                    for (int bj = 0; bj < 2; ++bj) st_bf8(rowp + bj * HALF, acc[ai][bj][m][0], acc[ai][bj][m][1]); }
        } else {
            bf16_t* base = (u.pn == pn_k) ? Kb : Vb;
            const size_t kvrow0 = is_ctx ? (size_t)(u.pm - 256) * 2304 + 2048 : (size_t)(u.pm >> 3) * 2304 + (size_t)(u.pm & 7) * 256;
#pragma unroll
            for (int ai = 0; ai < 2; ++ai)
#pragma unroll
                for (int m = 0; m < 4; ++m) { bf16_t* rowp = base + (kvrow0 + r_in + ai * HALF + m * 16) * 256 + cw;
#pragma unroll
                    for (int bj = 0; bj < 2; ++bj) st_bf8(rowp + bj * HALF, acc[ai][bj][m][0], acc[ai][bj][m][1]); }
        }
    }
};

template <class Epi, class Sched, bool ALIGN_EPI = false, bool SP2 = false>
__device__ __forceinline__ void gemm_phase(PG8_LAS unsigned char* lds, const Gemm g, const Sched& S, const Epi& E) {
    int tid_ = threadIdx.x; asm volatile("" : "+v"(tid_));
    const int tid = tid_, wid = __builtin_amdgcn_readfirstlane(tid >> 6), lane = tid & 63, wr = wid >> 2, wc = wid & 3, fr = lane & 15, fq = lane >> 4;
    const int K = g.K, nt = K / BK;
    unsigned voffA[2], voffB[2];
#pragma unroll
    for (int i = 0; i < 2; ++i) { int R, C; stage_rc(tid * 16 + i * 8192, R, C); const int Rb = Epi::PERM ? ((R & ~31) + perm32(R & 31)) : R;
        voffA[i] = (unsigned)(R * K + C) * 2u; voffB[i] = (unsigned)(Rb * K + C) * 2u; }
    const size_t kstep = (size_t)(BK * 2);
    const size_t hstep = (size_t)HALF * K * 2;
    const size_t tstep = 2 * hstep;
    const unsigned ldsw = (unsigned)wid * 1024u;
    const int aoff = lds_byte(wr * 64 + fr, fq * 8), boff = lds_byte(wc * 32 + fr, fq * 8);
#define PG8_SA(b, h) (((b) * 2 + (h)) * HTB)
#define PG8_SB(b, h) ((4 + (b) * 2 + (h)) * HTB)
#define PG8_STAGE(bufoff, gbase, voff) do { _Pragma("unroll") for (int _i = 0; _i < 2; ++_i) \
        __builtin_amdgcn_global_load_lds((const unsigned*)((const char*)(gbase) + (voff)[_i]), (PG8_LAS unsigned*)(lds + (bufoff) + ldsw + _i * 8192), 16, 0, 0); } while (0)
#define PG8_LDA(dst, b, h) do { _Pragma("unroll") for (int m = 0; m < 4; ++m) _Pragma("unroll") for (int k = 0; k < 2; ++k) dst[m][k] = *(const PG8_LAS bf16x8*)(lds + PG8_SA(b, h) + aoff + m * 2048 + k * 1024); } while (0)
#define PG8_LDB(dst, b, h) do { _Pragma("unroll") for (int n = 0; n < 2; ++n) _Pragma("unroll") for (int k = 0; k < 2; ++k) dst[n][k] = *(const PG8_LAS bf16x8*)(lds + PG8_SB(b, h) + boff + n * 2048 + k * 1024); } while (0)
#define PG8_MMA(ai, bj, At, Bt) do { __builtin_amdgcn_s_setprio(1); _Pragma("unroll") for (int m = 0; m < 4; ++m) _Pragma("unroll") for (int n = 0; n < 2; ++n) _Pragma("unroll") for (int k = 0; k < 2; ++k) \
        acc[ai][bj][m][n] = __builtin_amdgcn_mfma_f32_16x16x32_bf16(Bt[n][k], At[m][k], acc[ai][bj][m][n], 0, 0, 0); __builtin_amdgcn_s_setprio(0); } while (0)
#define PG8_WAIT_V(n) asm volatile("s_waitcnt vmcnt(" #n ")" ::: "memory")
#define PG8_WAIT_L(n) asm volatile("s_waitcnt lgkmcnt(" #n ")" ::: "memory")
#define PG8_BAR __builtin_amdgcn_s_barrier()
#define PG8_SCHED __builtin_amdgcn_sched_barrier(0)
    Unit cur, nxt; int ui = 0;
    if (!S.next(0, cur)) return;
    f32x4 acc[2][2][4][2];
#pragma unroll
    for (int a = 0; a < 2; ++a)
#pragma unroll
        for (int b = 0; b < 2; ++b)
#pragma unroll
            for (int m = 0; m < 4; ++m)
#pragma unroll
                for (int n = 0; n < 2; ++n) acc[a][b][m][n] = (f32x4){0.f, 0.f, 0.f, 0.f};
    bf16x8 At[4][2], B0[2][2], B1[2][2];
    const char* cA = (const char*)g.A + (size_t)cur.pm * tstep; const char* cB = (const char*)g.Bt + (size_t)cur.pn * tstep;
    S.a_ready(cur);
    if constexpr (SP2) {
        PG8_STAGE(PG8_SB(0, 0), cB, voffB); PG8_STAGE(PG8_SB(0, 1), cB + hstep, voffB); PG8_STAGE(PG8_SA(0, 0), cA, voffA); PG8_STAGE(PG8_SA(0, 1), cA + hstep, voffA);
        if (wr == 1) PG8_BAR;
        PG8_WAIT_V(2); PG8_BAR;
        PG8_STAGE(PG8_SB(1, 0), cB + kstep, voffB); PG8_STAGE(PG8_SA(1, 0), cA + kstep, voffA); PG8_STAGE(PG8_SB(1, 1), cB + hstep + kstep, voffB);
        PG8_WAIT_V(6); PG8_BAR;
    } else {
        PG8_STAGE(PG8_SB(0, 0), cB, voffB); PG8_STAGE(PG8_SA(0, 0), cA, voffA); PG8_STAGE(PG8_SB(0, 1), cB + hstep, voffB); PG8_STAGE(PG8_SA(0, 1), cA + hstep, voffA);
        if (wr == 1) PG8_BAR;
        PG8_WAIT_V(4); PG8_BAR;
        PG8_STAGE(PG8_SB(1, 0), cB + kstep, voffB); PG8_STAGE(PG8_SA(1, 0), cA + kstep, voffA); PG8_STAGE(PG8_SB(1, 1), cB + hstep + kstep, voffB);
        PG8_WAIT_V(6); PG8_BAR;
    }
    for (;;) {
        const bool has_next = S.next(ui + 1, nxt);
        const char* nA = has_next ? (const char*)g.A + (size_t)nxt.pm * tstep : cA; const char* nB = has_next ? (const char*)g.Bt + (size_t)nxt.pn * tstep : cB;
        for (int t = 0; t < nt; t += 2) {
            const bool last = (t == nt - 2);
            const char* a1 = cA + (size_t)(t + 1) * kstep;
            const char* a2 = last ? nA : cA + (size_t)(t + 2) * kstep; const char* b2 = last ? nB : cB + (size_t)(t + 2) * kstep;
            const char* a3 = a2 + kstep; const char* b3 = b2 + kstep;
            if (last && has_next) S.a_ready(nxt);
            if constexpr (SP2) {
            PG8_LDB(B0, 0, 0); PG8_LDB(B1, 0, 1); PG8_SCHED; PG8_LDA(At, 0, 0); PG8_STAGE(PG8_SA(1, 1), a1 + hstep, voffA);
            PG8_WAIT_V(8); PG8_WAIT_L(0); PG8_BAR; PG8_MMA(0, 0, At, B0); PG8_MMA(0, 1, At, B1); PG8_BAR; PG8_SCHED;
            PG8_LDA(At, 0, 1); PG8_STAGE(PG8_SB(0, 0), b2, voffB); PG8_STAGE(PG8_SB(0, 1), b2 + hstep, voffB); PG8_STAGE(PG8_SA(0, 0), a2, voffA);
            PG8_WAIT_V(8); PG8_WAIT_L(0); PG8_BAR; PG8_MMA(1, 0, At, B0); PG8_MMA(1, 1, At, B1); PG8_BAR; PG8_SCHED;
            PG8_LDB(B0, 1, 0); PG8_LDB(B1, 1, 1); PG8_SCHED; PG8_LDA(At, 1, 0); PG8_STAGE(PG8_SA(0, 1), a2 + hstep, voffA);
            PG8_WAIT_V(8); PG8_WAIT_L(0); PG8_BAR; PG8_MMA(0, 0, At, B0); PG8_MMA(0, 1, At, B1); PG8_BAR; PG8_SCHED;
            PG8_LDA(At, 1, 1); PG8_STAGE(PG8_SB(1, 0), b3, voffB); PG8_STAGE(PG8_SB(1, 1), b3 + hstep, voffB); PG8_STAGE(PG8_SA(1, 0), a3, voffA);
            PG8_WAIT_V(8); PG8_WAIT_L(0); PG8_BAR; PG8_MMA(1, 0, At, B0); PG8_MMA(1, 1, At, B1); PG8_BAR; PG8_SCHED;
            } else {
            PG8_LDB(B0, 0, 0); PG8_SCHED; PG8_LDA(At, 0, 0); PG8_STAGE(PG8_SA(1, 1), a1 + hstep, voffA);
            PG8_WAIT_L(8); PG8_BAR; PG8_WAIT_L(0); PG8_MMA(0, 0, At, B0); PG8_BAR; PG8_SCHED;
            PG8_LDB(B1, 0, 1); PG8_STAGE(PG8_SB(0, 0), b2, voffB);
            PG8_BAR; PG8_WAIT_L(0); PG8_MMA(0, 1, At, B1); PG8_BAR;
            PG8_LDA(At, 0, 1); PG8_STAGE(PG8_SA(0, 0), a2, voffA);
            PG8_BAR; PG8_WAIT_L(0); PG8_MMA(1, 0, At, B0); PG8_BAR; PG8_SCHED;
            PG8_STAGE(PG8_SB(0, 1), b2 + hstep, voffB);
            PG8_WAIT_V(6); PG8_BAR; PG8_MMA(1, 1, At, B1); PG8_BAR;
            PG8_LDB(B0, 1, 0); PG8_SCHED; PG8_LDA(At, 1, 0); PG8_STAGE(PG8_SA(0, 1), a2 + hstep, voffA);
            PG8_WAIT_L(8); PG8_BAR; PG8_WAIT_L(0); PG8_MMA(0, 0, At, B0); PG8_BAR; PG8_SCHED;
            PG8_LDB(B1, 1, 1); PG8_STAGE(PG8_SB(1, 0), b3, voffB);
            PG8_BAR; PG8_WAIT_L(0); PG8_MMA(0, 1, At, B1); PG8_BAR;
            PG8_LDA(At, 1, 1); PG8_STAGE(PG8_SA(1, 0), a3, voffA);
            PG8_BAR; PG8_WAIT_L(0); PG8_MMA(1, 0, At, B0); PG8_BAR; PG8_SCHED;
            PG8_STAGE(PG8_SB(1, 1), b3 + hstep, voffB);
            PG8_WAIT_V(6); PG8_BAR; PG8_MMA(1, 1, At, B1); PG8_BAR;
            }
        }
        if constexpr (ALIGN_EPI) { if (wr == 0) PG8_BAR; }
        if constexpr (!Epi::AFTER_DRAIN) { E(acc, cur, wr, wc, fr, fq); S.done(cur); }
        if (!has_next) break;
#pragma unroll
        for (int a = 0; a < 2; ++a)
#pragma unroll
            for (int b = 0; b < 2; ++b)
#pragma unroll
                for (int m = 0; m < 4; ++m)
#pragma unroll
                    for (int n = 0; n < 2; ++n) acc[a][b][m][n] = (f32x4){0.f, 0.f, 0.f, 0.f};
        cur = nxt; cA = nA; cB = nB; ++ui;
        if constexpr (ALIGN_EPI) { if (wr == 1) PG8_BAR; }
    }
    PG8_WAIT_V(0);
    if constexpr (!ALIGN_EPI) { if (wr == 0) PG8_BAR; }
    PG8_BAR;
    if constexpr (Epi::AFTER_DRAIN) { E.fused(acc, cur, wr, wc, fr, fq, lds, wid, lane); S.done(cur); }
#undef PG8_SA
#undef PG8_SB
#undef PG8_STAGE
#undef PG8_LDA
#undef PG8_LDB
#undef PG8_MMA
#undef PG8_WAIT_V
#undef PG8_WAIT_L
#undef PG8_BAR
#undef PG8_SCHED
}
}

namespace att {
typedef unsigned short bf16;
constexpr int   D = 128, NW = 8, QBLK = 32, KVBLK = 64;
constexpr float SCALE = 0.088388347648318440f;
constexpr float THR = 8.f;
constexpr int SDEPTH = 2;
constexpr int LDQ = 1024, LDK = 256, LDO = 1024;
constexpr size_t SHM_V = KVBLK * D * 2, SHM_K = KVBLK * D * 2, SHM_ATTN = 2 * SHM_V + 2 * SHM_K + NW * 64 * 4;
using bf16x8 = __attribute__((ext_vector_type(8))) short;
using s16x4  = __attribute__((ext_vector_type(4))) short;
using f32x16 = __attribute__((ext_vector_type(16))) float;
using f32x8  = __attribute__((ext_vector_type(8))) float;
using u32x4  = __attribute__((ext_vector_type(4))) unsigned;
#define KSWZ(row, colB) ((row) * 256 + ((colB) ^ (((row) & 7) << 4)))
#define SBAR() __builtin_amdgcn_sched_barrier(0)
__device__ __forceinline__ int crow(int r, int hi) { return (r & 3) + 8 * (r >> 2) + 4 * hi; }
__device__ __forceinline__ unsigned cvtpk(float lo, float hi) {
  unsigned r; asm volatile("v_cvt_pk_bf16_f32 %0, %1, %2" : "=v"(r) : "v"(lo), "v"(hi)); return r;
}
template <typename TIn> struct Stage;
template <> struct Stage<bf16>  { using T = bf16x8;
  __device__ static __forceinline__ T ld8(const bf16* p) { return *reinterpret_cast<const bf16x8*>(p); }
  __device__ static __forceinline__ bf16x8 tobf(T x) { return x; } };
template <> struct Stage<float> { using T = f32x8;
  __device__ static __forceinline__ T ld8(const float* p) { return *reinterpret_cast<const f32x8*>(p); }
  __device__ static __forceinline__ bf16x8 tobf(T x) {
    u32x4 w = {cvtpk(x[0], x[1]), cvtpk(x[2], x[3]), cvtpk(x[4], x[5]), cvtpk(x[6], x[7])}; return *reinterpret_cast<bf16x8*>(&w); } };

__device__ __forceinline__ void partialSM(f32x16& p0, f32x16& p1, float& m_reg, float& mn, float& alpha) {
  constexpr float C = SCALE * 1.4426950408889634f;
  float pmax = p0[0]; for (int r = 1; r < 16; ++r) pmax = fmaxf(pmax, p0[r]); for (int r = 0; r < 16; ++r) pmax = fmaxf(pmax, p1[r]);
  { auto rr = __builtin_amdgcn_permlane32_swap(__float_as_uint(pmax), __float_as_uint(pmax), false, false);
    pmax = fmaxf(__uint_as_float(rr[0]), __uint_as_float(rr[1])); }
  if (__builtin_expect(__all(pmax - m_reg <= THR / SCALE), 1)) { mn = m_reg; alpha = 1.f; }
  else { mn = fmaxf(m_reg, pmax); alpha = __builtin_amdgcn_exp2f((m_reg - mn) * C); m_reg = mn; }
  float mnC = -mn * C;
  for (int r = 0; r < 16; ++r) p0[r] = fmaf(p0[r], C, mnC); for (int r = 0; r < 16; ++r) p1[r] = fmaf(p1[r], C, mnC);
  for (int r = 0; r < 16; ++r) p0[r] = __builtin_amdgcn_exp2f(p0[r]);
}
__device__ __forceinline__ void finishSM(f32x16& p0, f32x16& p1, float alpha, float& l_reg, bf16x8& pa0, bf16x8& pa1, bf16x8& pa2, bf16x8& pa3) {
  for (int r = 0; r < 16; ++r) p1[r] = __builtin_amdgcn_exp2f(p1[r]);
  float ps = 0; for (int r = 0; r < 16; ++r) ps += p0[r]; for (int r = 0; r < 16; ++r) ps += p1[r];
  { auto rr = __builtin_amdgcn_permlane32_swap(__float_as_uint(ps), __float_as_uint(ps), false, false);
    ps = __uint_as_float(rr[0]) + __uint_as_float(rr[1]); }
  l_reg = l_reg * alpha + ps;
#define PK4(P, BASE, OUT) do { unsigned a0 = cvtpk(P[BASE + 0], P[BASE + 1]), a1 = cvtpk(P[BASE + 2], P[BASE + 3]);   \
    unsigned b0 = cvtpk(P[BASE + 4], P[BASE + 5]), b1 = cvtpk(P[BASE + 6], P[BASE + 7]);                              \
    auto r0 = __builtin_amdgcn_permlane32_swap(a0, b0, false, false); auto r1 = __builtin_amdgcn_permlane32_swap(a1, b1, false, false); \
    u32x4 w = {r0[0], r1[0], r0[1], r1[1]}; OUT = *reinterpret_cast<bf16x8*>(&w); } while (0)
  PK4(p0, 0, pa0); PK4(p0, 8, pa1); PK4(p1, 0, pa2); PK4(p1, 8, pa3);
#undef PK4
}
__device__ __forceinline__ void qkt(f32x16& p0, f32x16& p1, const bf16* Ks, const bf16x8* qr, int r32, int hi) {
  p0 = f32x16{}; p1 = f32x16{};
  for (int d0 = 0; d0 < 8; ++d0) { int cb = (d0 * 16 + hi * 8) * 2;
    bf16x8 b0 = *reinterpret_cast<const bf16x8*>((const char*)Ks + KSWZ(r32, cb));
    bf16x8 b1 = *reinterpret_cast<const bf16x8*>((const char*)Ks + KSWZ(32 + r32, cb));
    p0 = __builtin_amdgcn_mfma_f32_32x32x16_bf16(b0, qr[d0], p0, 0, 0, 0);
    p1 = __builtin_amdgcn_mfma_f32_32x32x16_bf16(b1, qr[d0], p1, 0, 0, 0); }
}
__device__ __forceinline__ int v_st(int k, int c) { const int kk = (k & ~0xC) | ((k & 4) << 1) | ((k & 8) >> 1); return ((kk >> 3) * 4 + (c >> 5)) * 512 + ((kk & 7) * 32 + (c & 31)) * 2; }
__device__ __forceinline__ int v_rd_base(int lane) { return ((lane & 3) << 3) | (((lane >> 2) & 3) << 6) | (((lane >> 4) & 1) << 5) | (((lane >> 5) & 1) << 8); }
constexpr int v_rd_off(int d0, int ks, int half) { return d0 * 512 + ks * 4096 + half * 2048; }
template <int OFF> __device__ __forceinline__ s16x4 tr_read(int vb) {
  s16x4 r; asm volatile("ds_read_b64_tr_b16 %0, %1 offset:%2" : "=&v"(r) : "v"(vb), "i"(OFF) : "memory"); return r;
}
template <int D0> __device__ __forceinline__ void pv_one(f32x16& od, int vb, bf16x8 pa0, bf16x8 pa1, bf16x8 pa2, bf16x8 pa3) {
  const s16x4 l0 = tr_read<v_rd_off(D0, 0, 0)>(vb), h0 = tr_read<v_rd_off(D0, 0, 1)>(vb), l1 = tr_read<v_rd_off(D0, 1, 0)>(vb), h1 = tr_read<v_rd_off(D0, 1, 1)>(vb);
  const s16x4 l2 = tr_read<v_rd_off(D0, 2, 0)>(vb), h2 = tr_read<v_rd_off(D0, 2, 1)>(vb), l3 = tr_read<v_rd_off(D0, 3, 0)>(vb), h3 = tr_read<v_rd_off(D0, 3, 1)>(vb);
  asm volatile("s_waitcnt lgkmcnt(0)" ::: "memory"); SBAR();
#define PK(L, H) (bf16x8){L[0], L[1], L[2], L[3], H[0], H[1], H[2], H[3]}
  od = __builtin_amdgcn_mfma_f32_32x32x16_bf16(pa0, PK(l0, h0), od, 0, 0, 0);
  od = __builtin_amdgcn_mfma_f32_32x32x16_bf16(pa1, PK(l1, h1), od, 0, 0, 0);
  od = __builtin_amdgcn_mfma_f32_32x32x16_bf16(pa2, PK(l2, h2), od, 0, 0, 0);
  od = __builtin_amdgcn_mfma_f32_32x32x16_bf16(pa3, PK(l3, h3), od, 0, 0, 0);
#undef PK
}
__device__ __forceinline__ void pv_d0(f32x16* o, int vb, bf16x8 pa0, bf16x8 pa1, bf16x8 pa2, bf16x8 pa3) {
  pv_one<0>(o[0], vb, pa0, pa1, pa2, pa3); pv_one<1>(o[1], vb, pa0, pa1, pa2, pa3); pv_one<2>(o[2], vb, pa0, pa1, pa2, pa3); pv_one<3>(o[3], vb, pa0, pa1, pa2, pa3);
}

template <typename TQ>
__device__ __forceinline__ void attn_dense_body(const TQ* __restrict__ Qb, const bf16* __restrict__ Kh, const bf16* __restrict__ Vh,
                                                bf16* __restrict__ Ob, int seq, char* lds) {
  using St = Stage<bf16>; using SQ = Stage<TQ>;
  int tid_ = threadIdx.x; asm volatile("" : "+v"(tid_));
  const int tid = tid_, wid = tid >> 6, lane = tid & 63, r32 = lane & 31, hi = lane >> 5;
  bf16* V_lds = (bf16*)lds; bf16* K_lds = (bf16*)(lds + 2 * SHM_V);
  float* ws = (float*)(lds + 2 * SHM_V + 2 * SHM_K) + wid * 64; float* li_l = ws; float* al_l = ws + 32;
  float m_reg = -1e30f, l_reg = 0; f32x16 o[4] = {}; bf16x8 qr[8];
  const TQ* Qw = Qb + (long)(wid * QBLK + r32) * LDQ + hi * 8;
#pragma unroll
  for (int d0 = 0; d0 < 8; ++d0) qr[d0] = SQ::tobf(SQ::ld8(Qw + d0 * 16));
  const int sr = tid >> 4, sc = (tid & 15) * 8, vst0 = v_st(sr, sc), vst1 = v_st(32 + sr, sc);
  const int vb0 = (int)(uintptr_t)V_lds + v_rd_base(lane);
  struct { typename St::T vs0, vs1, ks0, ks1; } sr_[SDEPTH];
#define SLOAD(i, k0) do { sr_[i].vs0 = St::ld8(&Vh[(long)((k0) + sr) * LDK + sc]); sr_[i].vs1 = St::ld8(&Vh[(long)((k0) + 32 + sr) * LDK + sc]); \
    sr_[i].ks0 = St::ld8(&Kh[(long)((k0) + sr) * LDK + sc]); sr_[i].ks1 = St::ld8(&Kh[(long)((k0) + 32 + sr) * LDK + sc]); } while (0)
#define SWRITE(b, i) do { *(bf16x8*)((char*)V_lds + (b) * SHM_V + vst0) = St::tobf(sr_[i].vs0);          \
    *(bf16x8*)((char*)V_lds + (b) * SHM_V + vst1) = St::tobf(sr_[i].vs1); int kc = sc * 2;               \
    *(bf16x8*)((char*)K_lds + (b) * SHM_K + KSWZ(sr, kc)) = St::tobf(sr_[i].ks0);                       \
    *(bf16x8*)((char*)K_lds + (b) * SHM_K + KSWZ(32 + sr, kc)) = St::tobf(sr_[i].ks1); } while (0)
#define SWAIT() do { if constexpr (SDEPTH == 2) asm volatile("s_waitcnt vmcnt(4)" ::: "memory"); else asm volatile("s_waitcnt vmcnt(0)" ::: "memory"); } while (0)
#define RESC(a) do { if (__any((a) < 1.f)) { if (hi == 0) al_l[r32] = (a); asm volatile("s_waitcnt lgkmcnt(0)" ::: "memory"); \
    for (int d = 0; d < 4; ++d) for (int r = 0; r < 16; ++r) o[d][r] *= al_l[crow(r, hi)]; } } while (0)
  f32x16 pA0, pA1, pB0, pB1; float mnA, mnB, alA, alB; bf16x8 pa0, pa1, pa2, pa3; const int NT = seq / KVBLK;
  constexpr int SE = 0, SO = SDEPTH - 1;
  SLOAD(SE, 0); asm volatile("s_waitcnt vmcnt(0)" ::: "memory"); SWRITE(0, SE); __syncthreads();
  qkt(pA0, pA1, K_lds, qr, r32, hi); partialSM(pA0, pA1, m_reg, mnA, alA);
  SLOAD(SO, KVBLK); if constexpr (SDEPTH == 2) { if (2 < NT) SLOAD(SE, 2 * KVBLK); }
  SWAIT(); SWRITE(1, SO); __syncthreads();
  for (int j = 1; j + 1 < NT; j += 2) {
    SBAR(); qkt(pB0, pB1, (bf16*)((char*)K_lds + SHM_K), qr, r32, hi);
    finishSM(pA0, pA1, alA, l_reg, pa0, pa1, pa2, pa3); SBAR();
    SLOAD(SO, (j + SDEPTH) * KVBLK); SBAR();
    pv_d0(o, vb0, pa0, pa1, pa2, pa3); partialSM(pB0, pB1, m_reg, mnB, alB);
    __syncthreads(); SWAIT(); SWRITE(0, SE);
    RESC(alB); __syncthreads();
    SBAR(); qkt(pA0, pA1, K_lds, qr, r32, hi);
    finishSM(pB0, pB1, alB, l_reg, pa0, pa1, pa2, pa3); SBAR();
    if (SDEPTH == 1 || j + 3 < NT) SLOAD(SE, (j + 1 + SDEPTH) * KVBLK); SBAR();
    pv_d0(o, vb0 + (int)SHM_V, pa0, pa1, pa2, pa3); partialSM(pA0, pA1, m_reg, mnA, alA);
    __syncthreads(); SWAIT(); SWRITE(1, SO);
    RESC(alA); __syncthreads();
  }
  SBAR(); qkt(pB0, pB1, (bf16*)((char*)K_lds + SHM_K), qr, r32, hi);
  finishSM(pA0, pA1, alA, l_reg, pa0, pa1, pa2, pa3); SBAR();
  pv_d0(o, vb0, pa0, pa1, pa2, pa3); partialSM(pB0, pB1, m_reg, mnB, alB);
  __syncthreads(); RESC(alB);
  finishSM(pB0, pB1, alB, l_reg, pa0, pa1, pa2, pa3); SBAR();
  pv_d0(o, vb0 + (int)SHM_V, pa0, pa1, pa2, pa3);
  if (hi == 0) li_l[r32] = l_reg; asm volatile("s_waitcnt lgkmcnt(0)" ::: "memory");
  float rli[16];
#pragma unroll
  for (int r = 0; r < 16; ++r) rli[r] = __builtin_amdgcn_rcpf(li_l[crow(r, hi)]);
  bf16* Ow = Ob + (long)(wid * QBLK) * LDO;
#pragma unroll
  for (int r = 0; r < 16; ++r) { int orow = crow(r, hi);
    for (int d0 = 0; d0 < 4; ++d0) Ow[(long)orow * LDO + d0 * 32 + r32] = (bf16)(cvtpk(o[d0][r] * rli[r], 0.f) & 0xffffu); }
#undef SLOAD
#undef SWRITE
#undef SWAIT
#undef RESC
}
}

#define LAS __attribute__((address_space(3)))
typedef unsigned short bf16;
typedef float f32x4 __attribute__((ext_vector_type(4)));
typedef unsigned v4u __attribute__((ext_vector_type(4)));
typedef unsigned v2u __attribute__((ext_vector_type(2)));
typedef short bf16x8 __attribute__((ext_vector_type(8)));

constexpr int NWAVES = 8, NTHR = 512;
constexpr int DM = 1024, NB = 32, SEQ = 2048, CTXL = 256, NLAT = NB * SEQ, NCTX = NB * CTXL, MT = NLAT + NCTX, FF = 2816, MIXIN = 2560, NQKV = 1536, SKV = SEQ + CTXL;
constexpr float LN_EPS = 1e-5f, RMS_EPS = 1e-6f;
constexpr size_t MiB = 1u << 20;
constexpr size_t WS_MOD = 1 * MiB, WS_ROPE = 3 * MiB, WS_WSGU = 4 * MiB, WS_WMIXIN = 5 * MiB, WS_WMIXOUT = 10 * MiB, WS_WFFNIN = 12 * MiB, WS_WFFNOUT = 34 * MiB,
                 WS_WQKV = 45 * MiB, WS_WAOUT = 48 * MiB, WS_STREAM = 50 * MiB, WS_YG = 194 * MiB, WS_H = 338 * MiB, WS_BIG = 482 * MiB, WS_END = 878 * MiB;
constexpr size_t BIG_K = 128 * MiB, BIG_V = 164 * MiB, BIG_O = 200 * MiB;
static_assert(WS_STREAM + (size_t)MT * DM * 2 <= WS_YG && WS_YG + (size_t)MT * DM * 2 <= WS_H && WS_H + (size_t)MT * DM * 2 <= WS_BIG && WS_BIG + (size_t)MT * FF * 2 <= WS_END, "ws map");
static_assert((size_t)NLAT * DM * 2 <= BIG_K && BIG_K + (size_t)NB * SKV * 256 * 2 <= BIG_V && BIG_V + (size_t)NB * SKV * 256 * 2 <= BIG_O, "ws map 2");
constexpr int LDS_BYTES = 147456;
constexpr int NPH = 16;

__device__ __forceinline__ float wave_sum(float v) {
#pragma unroll
    for (int o = 1; o < 64; o <<= 1) v += __shfl_xor(v, o);
    return v;
}
__device__ __forceinline__ unsigned pk2(float lo, float hi) { unsigned r; asm volatile("v_cvt_pk_bf16_f32 %0, %1, %2" : "=v"(r) : "v"(lo), "v"(hi)); return r; }
__device__ __forceinline__ float bflo(unsigned u) { return __uint_as_float(u << 16); }
__device__ __forceinline__ float bfhi(unsigned u) { return __uint_as_float(u & 0xffff0000u); }
__device__ __forceinline__ void unpack8(v4u r, float (&x)[8]) { x[0] = bflo(r.x); x[1] = bfhi(r.x); x[2] = bflo(r.y); x[3] = bfhi(r.y); x[4] = bflo(r.z); x[5] = bfhi(r.z); x[6] = bflo(r.w); x[7] = bfhi(r.w); }
__device__ __forceinline__ v4u pack8(const float (&x)[8]) { v4u w; w.x = pk2(x[0], x[1]); w.y = pk2(x[2], x[3]); w.z = pk2(x[4], x[5]); w.w = pk2(x[6], x[7]); return w; }

__device__ __forceinline__ int map_row(int kind, int n) {
    if (kind == 1) {
        if (n >= 512 && n < 1024) { const int q = n - 512; return 512 + 256 * (q >> 7) + (q & 127); }
        if (n >= 1024 && n < 1536) { const int q = n - 1024; return 512 + 256 * (q >> 7) + 128 + (q & 127); }
        return n;
    }
    if (kind == 2) { if (n < FF) return 256 * (n >> 7) + (n & 127); const int q = n - FF; return 256 * (q >> 7) + 128 + (q & 127); }
    return n;
}
__device__ __forceinline__ void transpose_item(const float* W, int K, int N, bf16* WT, int kind, LAS float* scr, int item, int lane) {
    const int nblk = N / 32, kb = item / nblk, nb = item % nblk, k0 = 64 * kb, n0 = 32 * nb;
#pragma unroll 8
    for (int i = 0; i < 32; ++i) { const int kk = 2 * i + (lane >> 5); scr[kk * 33 + (lane & 31)] = W[(size_t)(k0 + kk) * N + n0 + (lane & 31)]; }
    asm volatile("s_waitcnt lgkmcnt(0)" ::: "memory");
    const int c = lane & 7, pr0 = map_row(kind, n0);
#pragma unroll
    for (int j = 0; j < 4; ++j) { const int n = (lane >> 3) + 8 * j; const LAS float* s = scr + (8 * c) * 33 + n;
        v4u o; o.x = pk2(s[0 * 33], s[1 * 33]); o.y = pk2(s[2 * 33], s[3 * 33]); o.z = pk2(s[4 * 33], s[5 * 33]); o.w = pk2(s[6 * 33], s[7 * 33]);
        *(v4u*)(WT + (size_t)(pr0 + n) * K + k0 + 8 * c) = o; }
    asm volatile("s_waitcnt lgkmcnt(0)" ::: "memory");
}
__device__ __forceinline__ void adaln_task(int tk, const float* c, const float* c_ctx, const float* ada_w, const float* ada_b, float* mod, LAS float* T, int tid, int wave, int lane) {
    const int l = tk / 96, cb = tk % 96;
    const float* W = ada_w + (size_t)l * DM * 6144 + cb * 64 + lane;
    float acc[33];
#pragma unroll
    for (int bb = 0; bb < 33; ++bb) acc[bb] = 0.f;
    for (int half = 0; half < 2; ++half) {
        __syncthreads();
        for (int idx = tid; idx < 33 * 512; idx += NTHR) { const int bb = idx >> 9, kk = idx & 511, k = half * 512 + kk; const float cv = bb < 32 ? c[bb * DM + k] : c_ctx[k]; T[kk * 36 + bb] = cv / (1.0f + expf(-cv)); }
        __syncthreads();
        const int k0 = wave * 64;
        float wv[64];
#pragma unroll
        for (int j = 0; j < 64; ++j) wv[j] = W[(size_t)(half * 512 + k0 + j) * 6144];
#pragma unroll
        for (int j = 0; j < 64; ++j) {
#pragma unroll
            for (int bb = 0; bb < 33; ++bb) acc[bb] = fmaf(T[(k0 + j) * 36 + bb], wv[j], acc[bb]); }
    }
    __syncthreads();
#pragma unroll
    for (int bb = 0; bb < 33; ++bb) T[(wave * 33 + bb) * 64 + lane] = acc[bb];
    __syncthreads();
    for (int o = tid; o < 33 * 64; o += NTHR) { const int bb = o >> 6, ln = o & 63; float s = ada_b[l * 6144 + cb * 64 + ln];
#pragma unroll
        for (int w = 0; w < 8; ++w) s += T[(w * 33 + bb) * 64 + ln];
        mod[((size_t)l * 33 + bb) * 6144 + cb * 64 + ln] = s; }
    __syncthreads();
}
__device__ __forceinline__ void rope_entry(int gt, float* rope) {
    const int pos = gt >> 5, i = gt & 31;
    const float inv = exp2f(-(float)i * 0.41524101186092029f), angf = (float)pos * inv;
    const double x = (double)angf, k = rint(x * 0.63661977236758134);
    double r = fma(-k, 1.5707963267948966, x); r = fma(-k, 6.123233995736766e-17, r);
    const double r2 = r * r;
    const double sn = r * (1.0 + r2 * (-1.0 / 6 + r2 * (1.0 / 120 + r2 * (-1.0 / 5040 + r2 * (1.0 / 362880 + r2 * (-1.0 / 39916800 + r2 * (1.0 / 6227020800.0)))))));
    const double cs = 1.0 + r2 * (-0.5 + r2 * (1.0 / 24 + r2 * (-1.0 / 720 + r2 * (1.0 / 40320 + r2 * (-1.0 / 3628800 + r2 * (1.0 / 479001600.0))))));
    const int q = ((int)k) & 3;
    const double co = q == 0 ? cs : q == 1 ? -sn : q == 2 ? -cs : sn, si = q == 0 ? sn : q == 1 ? cs : q == 2 ? -sn : -cs;
    rope[2 * gt] = (float)co; rope[2 * gt + 1] = (float)si;
}

__device__ __forceinline__ void mod_rows(const float* xl, const float* xc, const float* modl, bf16* h, int gw, int NGW, int lane) {
    for (int m = gw; m < MT; m += NGW) {
        const float* src = m < NLAT ? xl + (size_t)m * DM : xc + (size_t)(m - NLAT) * DM;
        const int bb = m < NLAT ? (m >> 11) : 32;
        const f32x4* xr = (const f32x4*)src + lane; const f32x4* sh = (const f32x4*)(modl + (size_t)bb * 6144) + lane; const f32x4* sc = (const f32x4*)(modl + (size_t)bb * 6144 + 1024) + lane;
        v2u* o = (v2u*)(h + (size_t)m * DM) + lane;
#pragma unroll
        for (int j = 0; j < 4; ++j) { const f32x4 v = xr[64 * j], a = sc[64 * j], b = sh[64 * j]; const f32x4 y = v * (a + 1.0f) + b; v2u w; w.x = pk2(y[0], y[1]); w.y = pk2(y[2], y[3]); o[64 * j] = w; }
    }
}
typedef _Float16 h16x4 __attribute__((ext_vector_type(4)));
template <bool SRC32, bool DST32, bool HAS_H>
__device__ __forceinline__ void ln_rows(const void* xsrc_lat, const void* xsrc_ctx, const bf16* yg, void* dst, int row0, int nrows, const float* g, const float* b,
                                        const float* modn, int sh_off, int sc_off, bf16* h, int ws, int NS, int lane) {
    f32x4 gg[4], bv[4];
#pragma unroll
    for (int j = 0; j < 4; ++j) { gg[j] = ((const f32x4*)g)[lane + 64 * j]; bv[j] = ((const f32x4*)b)[lane + 64 * j]; }
    for (int m = row0 + 4 * ws; m < row0 + nrows; m += 4 * NS) {
        f32x4 v[4][4]; float s[4], s2[4];
#pragma unroll
        for (int r = 0; r < 4; ++r) {
            const v2u* yr = (const v2u*)(yg + (size_t)(m + r) * DM) + lane;
            if (SRC32) { const float* xp = m < NLAT ? (const float*)xsrc_lat + (size_t)(m + r) * DM : (const float*)xsrc_ctx + (size_t)(m + r - NLAT) * DM; const f32x4* xr = (const f32x4*)xp + lane;
#pragma unroll
                for (int j = 0; j < 4; ++j) v[r][j] = xr[64 * j]; }
            else { const h16x4* xr = (const h16x4*)((const _Float16*)xsrc_lat + (size_t)(m + r) * DM) + lane;
#pragma unroll
                for (int j = 0; j < 4; ++j) v[r][j] = __builtin_convertvector(xr[64 * j], f32x4); }
#pragma unroll
            for (int j = 0; j < 4; ++j) { const v2u w = yr[64 * j]; v[r][j] = v[r][j] * 1.4142135623730951f + (f32x4){bflo(w.x), bfhi(w.x), bflo(w.y), bfhi(w.y)}; }
        }
#pragma unroll
        for (int r = 0; r < 4; ++r) { float t = 0.f;
#pragma unroll
            for (int j = 0; j < 4; ++j) t += (v[r][j][0] + v[r][j][1]) + (v[r][j][2] + v[r][j][3]);
            s[r] = t; }
#pragma unroll
        for (int o = 1; o < 64; o <<= 1) {
#pragma unroll
            for (int r = 0; r < 4; ++r) s[r] += __shfl_xor(s[r], o); }
#pragma unroll
        for (int r = 0; r < 4; ++r) { const float mean = s[r] * (1.f / DM); float t = 0.f;
#pragma unroll
            for (int j = 0; j < 4; ++j) { v[r][j] = v[r][j] - mean; t += (v[r][j][0] * v[r][j][0] + v[r][j][1] * v[r][j][1]) + (v[r][j][2] * v[r][j][2] + v[r][j][3] * v[r][j][3]); }
            s2[r] = t; }
#pragma unroll
        for (int o = 1; o < 64; o <<= 1) {
#pragma unroll
            for (int r = 0; r < 4; ++r) s2[r] += __shfl_xor(s2[r], o); }
        const int bb = m < NLAT ? (m >> 11) : 32;
#pragma unroll
        for (int j = 0; j < 4; ++j) {
            f32x4 a = (f32x4){0.f, 0.f, 0.f, 0.f}, c = a;
            if (HAS_H) { a = ((const f32x4*)(modn + (size_t)bb * 6144 + sc_off))[lane + 64 * j] + 1.0f; c = ((const f32x4*)(modn + (size_t)bb * 6144 + sh_off))[lane + 64 * j]; }
#pragma unroll
            for (int r = 0; r < 4; ++r) { const float rstd = 1.0f / sqrtf(s2[r] * (1.f / DM) + LN_EPS);
                const f32x4 y = v[r][j] * rstd * gg[j] + bv[j];
                if (DST32) ((f32x4*)((float*)dst + (size_t)(m + r) * DM))[lane + 64 * j] = y;
                else ((h16x4*)((_Float16*)dst + (size_t)(m + r) * DM))[lane + 64 * j] = __builtin_convertvector(y, h16x4);
                if (HAS_H) { const f32x4 hv = y * a + c; v2u w; w.x = pk2(hv[0], hv[1]); w.y = pk2(hv[2], hv[3]); ((v2u*)(h + (size_t)(m + r) * DM))[lane + 64 * j] = w; } }
        }
    }
}
__device__ __forceinline__ void wg_fence() {
    asm volatile("s_waitcnt vmcnt(0)" ::: "memory");
    __syncthreads();
    __builtin_amdgcn_fence(__ATOMIC_ACQUIRE, "agent");
    asm volatile("s_waitcnt vmcnt(0)" ::: "memory");
}

__device__ __forceinline__ void mixer_core(const bf16* P, bf16* Y, const float* conv_w, const float* sln_g, const float* sln_b, const bf16* Wsg, const float* sgu_b,
                                           LAS unsigned char* lds, int G, int bid, int tid) {
    const int lane = tid & 63, wave = tid >> 6, fr = lane & 15, fq = lane >> 4;
    {
        const int c8 = lane * 8;
        float w0[8], w1[8], w2[8];
#pragma unroll
        for (int j = 0; j < 8; ++j) { w0[j] = conv_w[c8 + j]; w1[j] = conv_w[512 + c8 + j]; w2[j] = conv_w[1024 + c8 + j]; }
#pragma unroll 2
        for (int row = bid * NWAVES + wave; row < MT; row += G * NWAVES) {
            int pos, len; if (row < NLAT) { pos = row & (SEQ - 1); len = SEQ; } else { pos = (row - NLAT) & (CTXL - 1); len = CTXL; }
            const bf16* pr = P + (size_t)row * 2048;
            const v4u gb = *(const v4u*)(pr + c8), z0 = *(const v4u*)(pr + 512 + c8);
            v4u zm = (v4u){0u, 0u, 0u, 0u}, zp = (v4u){0u, 0u, 0u, 0u};
            if (pos > 0) zm = *(const v4u*)(pr - 2048 + 512 + c8);
            if (pos < len - 1) zp = *(const v4u*)(pr + 2048 + 512 + c8);
            float g_[8], a_[8], m_[8], p_[8], y[8];
            unpack8(gb, g_); unpack8(z0, a_); unpack8(zm, m_); unpack8(zp, p_);
#pragma unroll
            for (int j = 0; j < 8; ++j) y[j] = g_[j] * (w0[j] * m_[j] + w1[j] * a_[j] + w2[j] * p_[j]);
            *(v4u*)(Y + (size_t)row * DM + c8) = pack8(y);
        }
    }
    LAS float* stats = (LAS float*)lds;
    LAS bf16* vnt = (LAS bf16*)(lds + 1024) + wave * (32 * 136);
    for (int ch = bid; ch < MT / 128; ch += G) {
        const int row0 = ch * 128;
        __syncthreads();
        { v4u raw[16];
#pragma unroll
          for (int r = 0; r < 16; ++r) raw[r] = *(const v4u*)(P + (size_t)(row0 + wave * 16 + r) * 2048 + 1536 + lane * 8);
#pragma unroll
          for (int r = 0; r < 16; ++r) { const int rr = wave * 16 + r; float x[8]; unpack8(raw[r], x);
            float s = 0.f;
#pragma unroll
            for (int j = 0; j < 8; ++j) s += x[j];
            const float mean = wave_sum(s) * (1.f / 512.f); float q = 0.f;
#pragma unroll
            for (int j = 0; j < 8; ++j) { const float d = x[j] - mean; q += d * d; }
            const float rstd = 1.0f / sqrtf(wave_sum(q) * (1.f / 512.f) + LN_EPS);
            if (lane == 0) { stats[2 * rr] = mean; stats[2 * rr + 1] = rstd; } } }
        __syncthreads();
        const int g = wave;
        for (int dh = 0; dh < 2; ++dh) {
            const int cbase = 64 * g + 32 * dh, part = lane & 3, ql = lane >> 2;
            float lg[8], lb[8];
#pragma unroll
            for (int j = 0; j < 8; ++j) { lg[j] = sln_g[cbase + 8 * part + j]; lb[j] = sln_b[cbase + 8 * part + j]; }
#pragma unroll
            for (int it = 0; it < 8; ++it) { const int q = 16 * it + ql;
                const v4u raw = *(const v4u*)(P + (size_t)(row0 + q) * 2048 + 1536 + cbase + 8 * part); float x[8]; unpack8(raw, x);
                const float mean = stats[2 * q], rstd = stats[2 * q + 1];
#pragma unroll
                for (int j = 0; j < 8; j += 2) { const unsigned w = pk2((x[j] - mean) * rstd * lg[j] + lb[j], (x[j + 1] - mean) * rstd * lg[j + 1] + lb[j + 1]);
                    vnt[(8 * part + j) * 136 + q] = (bf16)(w & 0xffffu); vnt[(8 * part + j + 1) * 136 + q] = (bf16)(w >> 16); } }
            asm volatile("s_waitcnt lgkmcnt(0)" ::: "memory");
            f32x4 acc[2][8];
#pragma unroll
            for (int dt = 0; dt < 2; ++dt)
#pragma unroll
                for (int pt = 0; pt < 8; ++pt) acc[dt][pt] = (f32x4){0.f, 0.f, 0.f, 0.f};
#pragma unroll 1
            for (int ks = 0; ks < 4; ++ks) {
                bf16x8 af[2];
#pragma unroll
                for (int dt = 0; dt < 2; ++dt) af[dt] = *(const LAS bf16x8*)(vnt + (16 * dt + fr) * 136 + 32 * ks + 8 * fq);
#pragma unroll
                for (int pt = 0; pt < 8; ++pt) { const bf16x8 bw = *(const bf16x8*)(Wsg + ((size_t)g * 128 + 16 * pt + fr) * 128 + 32 * ks + 8 * fq);
#pragma unroll
                    for (int dt = 0; dt < 2; ++dt) acc[dt][pt] = __builtin_amdgcn_mfma_f32_16x16x32_bf16(af[dt], bw, acc[dt][pt], 0, 0, 0); }
            }
#pragma unroll
            for (int pt = 0; pt < 8; ++pt) { const int p = 16 * pt + fr; const float bs = sgu_b[g * 128 + p]; const size_t row = (size_t)row0 + p;
#pragma unroll
                for (int dt = 0; dt < 2; ++dt) { const int c = cbase + 16 * dt + 4 * fq; const v2u gu = *(const v2u*)(P + row * 2048 + 1024 + c);
                    v2u w; w.x = pk2(bflo(gu.x) * (acc[dt][pt][0] + bs), bfhi(gu.x) * (acc[dt][pt][1] + bs)); w.y = pk2(bflo(gu.y) * (acc[dt][pt][2] + bs), bfhi(gu.y) * (acc[dt][pt][3] + bs));
                    *(v2u*)(Y + row * DM + 512 + c) = w; } }
            asm volatile("s_waitcnt lgkmcnt(0)" ::: "memory");
        }
    }
}

__device__ __forceinline__ v4u norm_rope_chunk(v4u raw, int t, const float* gain, const float* rope, int lane) {
    const int l16 = lane & 15;
    float x[8]; unpack8(raw, x);
    float ss = 0.f;
#pragma unroll
    for (int j = 0; j < 8; ++j) ss += x[j] * x[j];
    ss += __shfl_xor(ss, 1); ss += __shfl_xor(ss, 2); ss += __shfl_xor(ss, 4); ss += __shfl_xor(ss, 8);
    const float rinv = 1.0f / sqrtf(ss * (1.f / 128.f) + RMS_EPS);
    float xn[8], pn[8], o[8];
#pragma unroll
    for (int j = 0; j < 8; ++j) xn[j] = x[j] * rinv * gain[8 * l16 + j];
#pragma unroll
    for (int j = 0; j < 8; ++j) pn[j] = __shfl_xor(xn[j], 4);
    const int a = l16 >> 3, s = (l16 >> 2) & 1, i0 = 8 * (l16 & 3);
    const int tt = t >= 0 ? t : 0, pa = a ? (tt & 63) : (tt >> 6);
    const f32x4* rp = (const f32x4*)(rope + (size_t)(pa * 32 + i0) * 2);
#pragma unroll
    for (int j2 = 0; j2 < 4; ++j2) { const f32x4 cs = rp[j2];
        const float r0 = s ? xn[2 * j2] * cs[0] + pn[2 * j2] * cs[1] : xn[2 * j2] * cs[0] - pn[2 * j2] * cs[1];
        const float r1 = s ? xn[2 * j2 + 1] * cs[2] + pn[2 * j2 + 1] * cs[3] : xn[2 * j2 + 1] * cs[2] - pn[2 * j2 + 1] * cs[3];
        o[2 * j2] = t >= 0 ? r0 : xn[2 * j2]; o[2 * j2 + 1] = t >= 0 ? r1 : xn[2 * j2 + 1]; }
    return pack8(o);
}
__device__ __forceinline__ void qk_norm_rope(bf16* Q, bf16* Kb, const float* q_g, const float* k_g, const float* rope, int gw, int NGW, int lane) {
    for (int r = 2 * gw; r < NLAT; r += 2 * NGW) {
        v4u* p = (v4u*)(Q + (size_t)r * DM) + lane; const int t = r & (SEQ - 1);
        const v4u a = p[0], b = p[64], c = p[128], d = p[192];
        p[0] = norm_rope_chunk(a, t, q_g, rope, lane); p[64] = norm_rope_chunk(b, t, q_g, rope, lane);
        p[128] = norm_rope_chunk(c, t + 1, q_g, rope, lane); p[192] = norm_rope_chunk(d, t + 1, q_g, rope, lane);
    }
    for (int rp = 2 * gw; rp < NB * SKV / 2; rp += 2 * NGW) {
        const int kr = 2 * rp + (lane >> 5), pos = kr % SKV, pos2 = (kr + 2) % SKV; v4u* p = (v4u*)(Kb + (size_t)kr * 256) + (lane & 31);
        const v4u a = p[0], b = p[64];
        p[0] = norm_rope_chunk(a, pos < SEQ ? pos : -1, k_g, rope, lane); p[64] = norm_rope_chunk(b, pos2 < SEQ ? pos2 : -1, k_g, rope, lane);
    }
}

struct Args { const float* in[21]; float* out; unsigned char* ws; int ph_lo, ph_hi; };
__global__ void __launch_bounds__(NTHR, 2) fwd_megakernel(Args a) {
    extern __shared__ __attribute__((aligned(16))) unsigned char lds_raw[];
    cg::grid_group grid = cg::this_grid();
    LAS unsigned char* lds = (LAS unsigned char*)lds_raw;
    const int tid = threadIdx.x, lane = tid & 63, wave = __builtin_amdgcn_readfirstlane(tid >> 6);
    const int G = gridDim.x, bid = blockIdx.x, gw = bid * NWAVES + wave, NGW = G * NWAVES;
    const int lo = a.ph_lo, hi = a.ph_hi;
    unsigned char* ws = a.ws;
    const float *x_in = a.in[0], *c_in = a.in[1], *ctx_in = a.in[2], *cctx_in = a.in[3], *ada_w = a.in[4], *ada_b = a.in[5], *ln_g = a.in[6], *ln_b = a.in[7],
                *ffn_w_in = a.in[8], *ffn_w_out = a.in[9], *mix_w_in = a.in[10], *conv_w = a.in[11], *sgu_ln_g = a.in[12], *sgu_ln_b = a.in[13], *sgu_w = a.in[14], *sgu_b = a.in[15],
                *mix_w_out = a.in[16], *attn_w_qkv = a.in[17], *q_norm_g = a.in[18], *k_norm_g = a.in[19], *attn_w_out = a.in[20];
    float* mod = (float*)(ws + WS_MOD); float* rope = (float*)(ws + WS_ROPE);
    bf16 *Wsg = (bf16*)(ws + WS_WSGU), *Wmixin = (bf16*)(ws + WS_WMIXIN), *Wmixout = (bf16*)(ws + WS_WMIXOUT), *Wffnin = (bf16*)(ws + WS_WFFNIN), *Wffnout = (bf16*)(ws + WS_WFFNOUT),
         *Wqkv = (bf16*)(ws + WS_WQKV), *Waout = (bf16*)(ws + WS_WAOUT);
    _Float16* stream = (_Float16*)(ws + WS_STREAM);
    bf16* YG = (bf16*)(ws + WS_YG);
    bf16* H = (bf16*)(ws + WS_H);
    bf16* BIG = (bf16*)(ws + WS_BIG);
    bf16 *Qb = BIG, *Kb = (bf16*)(ws + WS_BIG + BIG_K), *Vb = (bf16*)(ws + WS_BIG + BIG_V), *Ob = (bf16*)(ws + WS_BIG + BIG_O);
#ifndef PHASE_MASK
#define PHASE_MASK 0x1ffff
#endif
#define IN(k) ((((PHASE_MASK) >> (k)) & 1) && lo <= (k) && (k) < hi)
#ifndef TIME_MASK
#define TIME_MASK 0
#endif
    unsigned long long tp0 = 0;
#define TIMED(k) ((((TIME_MASK) >> (k)) & 1) != 0)
#define TBEG(k) do { if (TIMED(k)) tp0 = __builtin_amdgcn_s_memrealtime(); } while (0)
#define SEAM(k) do { if (IN(k) && IN((k) + 1)) grid.sync(); \
        if (TIMED(k)) { const unsigned long long tp1 = __builtin_amdgcn_s_memrealtime(); while (__builtin_amdgcn_s_memrealtime() - tp1 < tp1 - tp0) __builtin_amdgcn_s_sleep(8); } } while (0)

    TBEG(0); if (IN(0)) {
        for (int tk = bid; tk < 192; tk += G) adaln_task(tk, c_in, cctx_in, ada_w, ada_b, mod, (LAS float*)lds, tid, wave, lane);
        __syncthreads();
        { const int gt = bid * NTHR + tid; if (gt < 64 * 32) rope_entry(gt, rope); }
        for (int i = bid * NTHR + tid; i < 8 * 128 * 128 / 2; i += G * NTHR) ((unsigned*)Wsg)[i] = pk2(sgu_w[2 * i], sgu_w[2 * i + 1]);
        LAS float* scr = (LAS float*)(lds + wave * 16384);
        constexpr int I_MI = (DM / 64) * (MIXIN / 32), I_MO = (DM / 64) * (DM / 32), I_FI = (DM / 64) * (2 * FF / 32), I_FO = (FF / 64) * (DM / 32), I_QKV = (DM / 64) * (NQKV / 32), I_AO = I_MO;
        constexpr int NITEMS = I_MI + I_MO + 2 * I_FI + 2 * I_FO + I_QKV + I_AO;
        for (int it = gw; it < NITEMS; it += NGW) {
            int r = it;
            if (r < I_MI) { transpose_item(mix_w_in, DM, MIXIN, Wmixin, 1, scr, r, lane); continue; } r -= I_MI;
            if (r < I_MO) { transpose_item(mix_w_out, DM, DM, Wmixout, 0, scr, r, lane); continue; } r -= I_MO;
            if (r < I_FI) { transpose_item(ffn_w_in, DM, 2 * FF, Wffnin, 2, scr, r, lane); continue; } r -= I_FI;
            if (r < I_FI) { transpose_item(ffn_w_in + (size_t)DM * 2 * FF, DM, 2 * FF, Wffnin + (size_t)2 * FF * DM, 2, scr, r, lane); continue; } r -= I_FI;
            if (r < I_FO) { transpose_item(ffn_w_out, FF, DM, Wffnout, 0, scr, r, lane); continue; } r -= I_FO;
            if (r < I_FO) { transpose_item(ffn_w_out + (size_t)FF * DM, FF, DM, Wffnout + (size_t)DM * FF, 0, scr, r, lane); continue; } r -= I_FO;
            if (r < I_QKV) { transpose_item(attn_w_qkv, DM, NQKV, Wqkv, 0, scr, r, lane); continue; } r -= I_QKV;
            transpose_item(attn_w_out, DM, DM, Waout, 0, scr, r, lane);
        }
        __syncthreads();
    }
    SEAM(0);
    TBEG(1); if (IN(1)) mod_rows(x_in, ctx_in, mod, H, gw, NGW, lane);
    SEAM(1);

    TBEG(2); if (IN(2)) { pg8::Gemm g{H, Wmixin, MT, MIXIN, DM}; pg8::StaticOrder S; S.init(MT, MIXIN, G, bid); pg8::EpiMixIn E{BIG};
        pg8::gemm_phase<pg8::EpiMixIn, pg8::StaticOrder, true, true>(lds, g, S, E); }
    SEAM(2);
    TBEG(3); if (IN(3)) mixer_core(BIG, H, conv_w, sgu_ln_g, sgu_ln_b, Wsg, sgu_b, lds, G, bid, tid);
    SEAM(3);
#define LAYER_TAIL(L_, PB, NCTXU, M_, AOP, WOUT, S32, SRC_LAT, SRC_CTX)                                                                                             \
    TBEG(4 + PB); if (IN(4 + PB)) { pg8::Gemm g{AOP, WOUT, M_, DM, DM}; pg8::ResidOrder S{bid, NCTXU};                                                              \
        pg8::EpiGateY E{YG, mod + (size_t)L_ * 33 * 6144 + 2048};                                                                                                   \
        pg8::gemm_phase<pg8::EpiGateY, pg8::ResidOrder, true, true>(lds, g, S, E);                                                                                  \
        wg_fence();                                                                                                                                                 \
        ln_rows<S32, false, true>(SRC_LAT, SRC_CTX, YG, stream, bid * 256, 256, ln_g + (size_t)(2 * L_) * DM, ln_b + (size_t)(2 * L_) * DM, mod + (size_t)L_ * 33 * 6144, 3072, 4096, H, wave, NWAVES, lane); } \
    SEAM(4 + PB);                                                                                                                                                   \
    TBEG(5 + PB); if (IN(5 + PB) && NCTXU) ln_rows<S32, false, true>(SRC_LAT, SRC_CTX, YG, stream, NLAT, NCTX, ln_g + (size_t)(2 * L_) * DM, ln_b + (size_t)(2 * L_) * DM, mod + (size_t)L_ * 33 * 6144, 3072, 4096, H, gw, NGW, lane); \
    if (NCTXU) SEAM(5 + PB);                                                                                                                                        \
    TBEG(6 + PB); if (IN(6 + PB)) { pg8::Gemm g{H, Wffnin + (size_t)L_ * 2 * FF * DM, M_, 2 * FF, DM}; pg8::StaticOrder S; S.init(M_, 2 * FF, G, bid); pg8::EpiSwiglu E{BIG};     \
        pg8::gemm_phase<pg8::EpiSwiglu, pg8::StaticOrder, true, true>(lds, g, S, E); }                                                                              \
    SEAM(6 + PB);
    LAYER_TAIL(0, 0, 128, MT, H, Wmixout, true, x_in, ctx_in)
    TBEG(7); if (IN(7)) { pg8::Gemm g{BIG, Wffnout, MT, DM, FF}; pg8::ResidOrder S{bid, 128};
        pg8::EpiGateY E{YG, mod + 5120};
        pg8::gemm_phase<pg8::EpiGateY, pg8::ResidOrder, true, true>(lds, g, S, E);
        wg_fence();
        ln_rows<false, false, true>(stream, stream, YG, stream, bid * 256, 256, ln_g + DM, ln_b + DM, mod + (size_t)33 * 6144, 0, 1024, H, wave, NWAVES, lane); }
    SEAM(7);
    TBEG(8); if (IN(8)) ln_rows<false, false, true>(stream, stream, YG, stream, NLAT, NCTX, ln_g + DM, ln_b + DM, mod + (size_t)33 * 6144, 0, 1024, H, gw, NGW, lane);
    SEAM(8);
    TBEG(9); if (IN(9)) { pg8::Gemm g{H, Wqkv, MT, NQKV, DM}; pg8::QkvOrder S; S.init(NLAT, NQKV, G, bid); pg8::EpiQKV E{Qb, Kb, Vb};
        pg8::gemm_phase<pg8::EpiQKV, pg8::QkvOrder, true, true>(lds, g, S, E); }
    SEAM(9);
    TBEG(10); if (IN(10)) qk_norm_rope(Qb, Kb, q_norm_g, k_norm_g, rope, gw, NGW, lane);
    SEAM(10);
    TBEG(11); if (IN(11)) {
        for (int L = bid; L < NB * 8 * (SEQ / 256); L += G) {
            const int round = L >> 8, c = L & 255, xq = c & 7, s = c >> 3;
            const int b = 4 * round + (xq >> 1), kvh = xq & 1, h = 4 * kvh + (s >> 3), qb = s & 7;
            const size_t qoff = ((size_t)b * SEQ + 256 * qb) * DM + 128 * h, koff = (size_t)b * SKV * 256 + 128 * kvh;
            att::attn_dense_body<att::bf16>(Qb + qoff, Kb + koff, Vb + koff, Ob + qoff, SKV, (char*)lds_raw);
            __syncthreads();
        }
    }
    SEAM(11);
    LAYER_TAIL(1, 8, 0, NLAT, Ob, Waout, false, stream, stream)
    TBEG(15); if (IN(15)) { pg8::Gemm g{BIG, Wffnout + (size_t)DM * FF, NLAT, DM, FF}; pg8::ResidOrder S{bid, 0};
        pg8::EpiGateY E{YG, mod + (size_t)33 * 6144 + 5120};
        pg8::gemm_phase<pg8::EpiGateY, pg8::ResidOrder, true, true>(lds, g, S, E);
        wg_fence();
        ln_rows<false, true, false>(stream, stream, YG, a.out, bid * 256, 256, ln_g + 3 * DM, ln_b + 3 * DM, nullptr, 0, 0, nullptr, wave, NWAVES, lane); }
    SEAM(15);
#undef LAYER_TAIL
#undef IN
#undef SEAM
}

#ifndef MK_PER_PHASE
#define MK_PER_PHASE 0
#endif
extern "C" void kernel_launch(void* const* d_in, const int* in_sizes, int n_in, void* d_out, int out_size, void* d_ws, size_t ws_size, hipStream_t stream) {
    static int grid = 0;
    if (grid == 0) {
        if (n_in != 21 || in_sizes[0] != NLAT * DM || out_size != NLAT * DM || ws_size < WS_END) {
            fprintf(stderr, "kernel_launch: unexpected shapes: n_in %d in0 %d out %d ws %zu (need %zu)\n", n_in, n_in > 0 ? in_sizes[0] : -1, out_size, ws_size, (size_t)WS_END); grid = -1; return; }
        int dev = 0, cus = 0, per_cu = 0;
        if (hipGetDevice(&dev) != hipSuccess || hipDeviceGetAttribute(&cus, hipDeviceAttributeMultiprocessorCount, dev) != hipSuccess) { fprintf(stderr, "kernel_launch: device query failed\n"); grid = -1; return; }
        if (hipFuncSetAttribute((const void*)fwd_megakernel, hipFuncAttributeMaxDynamicSharedMemorySize, LDS_BYTES) != hipSuccess) { fprintf(stderr, "kernel_launch: hipFuncSetAttribute failed\n"); grid = -1; return; }
        if (hipOccupancyMaxActiveBlocksPerMultiprocessor(&per_cu, (const void*)fwd_megakernel, NTHR, LDS_BYTES) != hipSuccess || per_cu < 1) { fprintf(stderr, "kernel_launch: occupancy query says %d blocks per CU\n", per_cu); per_cu = 1; }
        (void)hipGetLastError();
        grid = cus * per_cu;
        if (grid != 256) { fprintf(stderr, "kernel_launch: this kernel needs a 256-workgroup co-resident grid (one per CU), got %d\n", grid); grid = -1; return; }
        fprintf(stderr, "kernel_launch: %d CUs x %d = grid %d\n", cus, per_cu, grid);
    }
    if (grid < 0) return;
    Args a{};
    for (int i = 0; i < 21; ++i) a.in[i] = (const float*)d_in[i];
    a.out = (float*)d_out; a.ws = (unsigned char*)d_ws;
#if MK_PER_PHASE
    for (int ph = 0; ph < NPH; ++ph) { a.ph_lo = ph; a.ph_hi = ph + 1; hipLaunchKernelGGL(fwd_megakernel, dim3(grid), dim3(NTHR), LDS_BYTES, stream, a); }
#else
    a.ph_lo = 0; a.ph_hi = NPH;
    void* args[] = {&a};
    const hipError_t e = hipLaunchCooperativeKernel((const void*)fwd_megakernel, dim3(grid), dim3(NTHR), args, LDS_BYTES, stream);
    if (e != hipSuccess) fprintf(stderr, "kernel_launch: cooperative launch failed: %s (grid %d)\n", hipGetErrorString(e), grid);
#endif
}
```
